# Optimizing an MI355X kernel written in HIP

```python
import jax, jax.numpy as jnp
from jax import lax
import numpy as np

D_MODEL = 1024
BATCH = 8
SEQ = 4096
DEPTH = 2

HEAD_DIM = 64
D_MIX = D_MODEL
CONV_WIDTH = D_MIX // 2
N_CONV_GROUPS = CONV_WIDTH // HEAD_DIM
ATTN_WIDTH = D_MIX - CONV_WIDTH
N_Q_HEADS = ATTN_WIDTH // HEAD_DIM
N_KV_GROUPS = 2
Q_PER_KV = N_Q_HEADS // N_KV_GROUPS
KV_WIDTH = N_KV_GROUPS * HEAD_DIM
N_GATES = 3
CMP_LEN = 32
CMP_STRIDE = 16
CMP_HIDDEN = 256
SLC_LEN = 64
SLC_TOPK = 16
WINDOW = 512
Q_CHUNK = 32
ROPE_THETA = 500000.0
ROPE_DIM = HEAD_DIM // 4
CONV_K = 3
FFN_CONV_K = 3
D_FF = 2816
ALPHA = (2.0 * DEPTH) ** 0.25
BETA = (8.0 * DEPTH) ** -0.25
NEG = -1e30
BIG = 1e9

kernel_name = 'hymba_shortconv_nsa_convffn_deepnorm'


def _in_split_points():
    sizes = [CONV_WIDTH] * 3 + [ATTN_WIDTH] + [KV_WIDTH] * 6 + [N_Q_HEADS * N_GATES]
    return [int(v) for v in np.cumsum(sizes)[:-1]], int(sum(sizes))


def _layer_norm(x, g, b, eps=1e-5):
    x32 = x.astype(jnp.float32)
    mu = jnp.mean(x32, -1, keepdims=True)
    var = jnp.mean(jnp.square(x32 - mu), -1, keepdims=True)
    return ((x32 - mu) * lax.rsqrt(var + eps) * g + b).astype(x.dtype)


def _head_rmsnorm(y, g, eps=1e-6):
    B, T, W = y.shape
    y32 = y.astype(jnp.float32).reshape(B, T, W // HEAD_DIM, HEAD_DIM)
    y32 = y32 * lax.rsqrt(jnp.mean(jnp.square(y32), -1, keepdims=True) + eps)
    return (y32.reshape(B, T, W) * g).astype(y.dtype)


def _causal_dwconv(z, w):
    K = w.shape[0]
    T = z.shape[1]
    zp = jnp.pad(z, ((0, 0), (K - 1, 0), (0, 0)))
    return sum(zp[:, k:k + T] * w[k] for k in range(K))


def _rope_tables(T):
    half = ROPE_DIM // 2
    inv_freq = ROPE_THETA ** (-(np.arange(half, dtype=np.float32) * 2.0 / ROPE_DIM))
    ang = jnp.arange(T, dtype=jnp.float32)[:, None] * jnp.asarray(inv_freq, jnp.float32)[None]
    return jnp.cos(ang)[:, None, :], jnp.sin(ang)[:, None, :]


def _partial_rope(x, cos, sin):
    half = ROPE_DIM // 2
    x1, x2, xp = x[..., :half], x[..., half:ROPE_DIM], x[..., ROPE_DIM:]
    rot = jnp.concatenate([x1 * cos - x2 * sin, x2 * cos + x1 * sin], -1).astype(x.dtype)
    return jnp.concatenate([rot, xp], -1)


def _masked_softmax(s, mask):
    s32 = jnp.where(mask, s.astype(jnp.float32), NEG)
    return jnp.where(mask, jax.nn.softmax(s32, axis=-1), 0.0)


def _slc_aggregation(T):
    nc = T // CMP_STRIDE - CMP_LEN // CMP_STRIDE + 1
    ns = T // SLC_LEN
    sc = np.arange(nc)[:, None] * CMP_STRIDE
    ss = np.arange(ns)[None, :] * SLC_LEN
    ov = np.clip(np.minimum(sc + CMP_LEN, ss + SLC_LEN) - np.maximum(sc, ss), 0, None)
    return jnp.asarray(ov / CMP_LEN, dtype=jnp.float32)


def _compress(a, pe, w1, b1, w2, b2):
    B, G, T, dk = a.shape
    r = CMP_LEN // CMP_STRIDE
    nsub = T // CMP_STRIDE
    nc = nsub - r + 1
    sub = a.reshape(B, G, nsub, CMP_STRIDE, dk)
    blocks = jnp.concatenate([sub[:, :, j:j + nc] for j in range(r)], axis=3)
    blocks = (blocks + pe).reshape(B, G, nc, CMP_LEN * dk)
    return jax.nn.gelu(blocks @ w1 + b1) @ w2 + b2


def _nsa(q, kc, vc, ks, vs, kw, vw, gates, pe, w1, b1, w2, b2):
    B, T, H, dk = q.shape
    G, R = N_KV_GROUPS, Q_PER_KV
    scale = dk ** -0.5
    qg = q.reshape(B, T, G, R, dk).transpose(0, 2, 3, 1, 4)
    to_g = lambda a: a.transpose(0, 2, 1, 3)
    k_cmp = _compress(to_g(kc), pe[0], w1[0], b1[0], w2[0], b2[0])
    v_cmp = _compress(to_g(vc), pe[1], w1[1], b1[1], w2[1], b2[1])
    nc = k_cmp.shape[2]
    cmp_end = jnp.arange(nc) * CMP_STRIDE + CMP_LEN - 1
    agg = _slc_aggregation(T)
    ns = T // SLC_LEN
    topk = min(SLC_TOPK, ns)
    kb_s = to_g(ks).reshape(B, G, ns, SLC_LEN, dk)
    vb_s = to_g(vs).reshape(B, G, ns, SLC_LEN, dk)
    pad = ((0, 0), (0, 0), (WINDOW, 0), (0, 0))
    kw_p = jnp.pad(to_g(kw), pad)
    vw_p = jnp.pad(to_g(vw), pad)
    blk = jnp.arange(ns)
    gather = jax.vmap(jax.vmap(lambda kb, ix: kb[ix]))

    def chunk(s):
        t = s + jnp.arange(Q_CHUNK)
        qc = lax.dynamic_slice_in_dim(qg, s, Q_CHUNK, axis=3) * scale
        sc = jnp.einsum('bgrqd,bgcd->bgrqc', qc, k_cmp)
        p_cmp = _masked_softmax(sc, cmp_end[None, :] <= t[:, None])
        o_cmp = jnp.einsum('bgrqc,bgcd->bgrqd', p_cmp, v_cmp)
        imp = jnp.einsum('bgrqc,cs->bgqs', p_cmp, agg)
        tb = t // SLC_LEN
        forced = (blk[None] == 0) | (blk[None] == tb[:, None]) | (blk[None] == tb[:, None] - 1)
        score = jnp.where(forced, BIG, imp)
        score = jnp.where(blk[None] <= tb[:, None], score, -BIG)
        _, idx = lax.top_k(score, topk)
        ks_sel = gather(kb_s, idx)
        vs_sel = gather(vb_s, idx).reshape(B, G, Q_CHUNK, topk * SLC_LEN, dk)
        ss = jnp.einsum('bgrqd,bgqnld->bgrqnl', qc, ks_sel).reshape(B, G, R, Q_CHUNK, topk * SLC_LEN)
        key_pos = idx[..., None] * SLC_LEN + jnp.arange(SLC_LEN)
        ms = (key_pos <= t[:, None, None]).reshape(B, G, 1, Q_CHUNK, topk * SLC_LEN)
        o_slc = jnp.einsum('bgrqm,bgqmd->bgrqd', _masked_softmax(ss, ms), vs_sel)
        kwin = lax.dynamic_slice_in_dim(kw_p, s, Q_CHUNK + WINDOW, axis=2)
        vwin = lax.dynamic_slice_in_dim(vw_p, s, Q_CHUNK + WINDOW, axis=2)
        wpos = s - WINDOW + jnp.arange(Q_CHUNK + WINDOW)
        mw = (wpos[None] <= t[:, None]) & (wpos[None] > t[:, None] - WINDOW) & (wpos[None] >= 0)
        sw = jnp.einsum('bgrqd,bgkd->bgrqk', qc, kwin)
        o_win = jnp.einsum('bgrqk,bgkd->bgrqd', _masked_softmax(sw, mw), vwin)
        return o_cmp, o_slc, o_win

    starts = jnp.arange(T // Q_CHUNK) * Q_CHUNK
    o_c, o_s, o_w = lax.map(chunk, starts)
    unchunk = lambda o: o.transpose(1, 0, 4, 2, 3, 5).reshape(B, T, H, dk)
    g = jax.nn.sigmoid(gates.astype(jnp.float32))
    out = g[..., 0:1] * unchunk(o_c) + g[..., 1:2] * unchunk(o_s) + g[..., 2:3] * unchunk(o_w)
    return out.astype(q.dtype).reshape(B, T, H * dk)


def setup_inputs(seed: int = 0) -> dict:
    key = jax.random.key(seed)
    ks = jax.random.split(key, 20)
    _, in_cols = _in_split_points()
    nrm = lambda k, shape, s: jax.random.normal(k, shape, jnp.float32) * s
    L = DEPTH
    return {
        'x': nrm(ks[0], (BATCH, SEQ, D_MODEL), 1.0),
        'w_in': nrm(ks[1], (L, D_MODEL, in_cols), D_MODEL ** -0.5),
        'short_conv_w': nrm(ks[2], (L, CONV_K, CONV_WIDTH), CONV_K ** -0.5),
        'cmp_pe': nrm(ks[3], (L, 2, CMP_LEN, HEAD_DIM), 0.02),
        'cmp_w1': nrm(ks[4], (L, 2, CMP_LEN * HEAD_DIM, CMP_HIDDEN), (CMP_LEN * HEAD_DIM) ** -0.5),
        'cmp_b1': nrm(ks[5], (L, 2, CMP_HIDDEN), 0.01),
        'cmp_w2': nrm(ks[6], (L, 2, CMP_HIDDEN, HEAD_DIM), CMP_HIDDEN ** -0.5),
        'cmp_b2': nrm(ks[7], (L, 2, HEAD_DIM), 0.01),
        'head_norm_g': 1.0 + nrm(ks[8], (L, D_MIX), 0.02),
        'w_out': nrm(ks[9], (L, D_MIX, D_MODEL), BETA * D_MIX ** -0.5),
        'ln1_g': 1.0 + nrm(ks[10], (L, D_MODEL), 0.02),
        'ln1_b': nrm(ks[11], (L, D_MODEL), 0.01),
        'w_up': nrm(ks[12], (L, D_MODEL, 2 * D_FF), D_MODEL ** -0.5),
        'ffn_conv_w': nrm(ks[13], (L, FFN_CONV_K, 2 * D_FF), FFN_CONV_K ** -0.5),
        'ffn_conv_b': nrm(ks[14], (L, 2 * D_FF), 0.01),
        'w_down': nrm(ks[15], (L, D_FF, D_MODEL), BETA * D_FF ** -0.5),
        'ln2_g': 1.0 + nrm(ks[16], (L, D_MODEL), 0.02),
        'ln2_b': nrm(ks[17], (L, D_MODEL), 0.01),
    }


def reference(x, w_in, short_conv_w, cmp_pe, cmp_w1, cmp_b1, cmp_w2, cmp_b2, head_norm_g,
              w_out, ln1_g, ln1_b, w_up, ffn_conv_w, ffn_conv_b, w_down, ln2_g, ln2_b):
    B, T, _ = x.shape
    split_points, _ = _in_split_points()
    cos, sin = _rope_tables(T)
    for i in range(DEPTH):
        proj = x @ w_in[i]
        (b_g, c_g, h, q, kc, vc, k_s, v_s, k_w, v_w, gates) = jnp.split(proj, split_points, axis=-1)
        conv_out = b_g * _causal_dwconv(c_g * h, short_conv_w[i])
        heads = lambda a, n: a.reshape(B, T, n, HEAD_DIM)
        q = _partial_rope(heads(q, N_Q_HEADS), cos, sin)
        kc = _partial_rope(heads(kc, N_KV_GROUPS), cos, sin)
        k_s = _partial_rope(heads(k_s, N_KV_GROUPS), cos, sin)
        k_w = _partial_rope(heads(k_w, N_KV_GROUPS), cos, sin)
        attn_out = _nsa(q, kc, heads(vc, N_KV_GROUPS), k_s, heads(v_s, N_KV_GROUPS), k_w,
                        heads(v_w, N_KV_GROUPS), gates.reshape(B, T, N_Q_HEADS, N_GATES),
                        cmp_pe[i], cmp_w1[i], cmp_b1[i], cmp_w2[i], cmp_b2[i])
        mixed = _head_rmsnorm(jnp.concatenate([conv_out, attn_out], -1), head_norm_g[i])
        x = _layer_norm(ALPHA * x + mixed @ w_out[i], ln1_g[i], ln1_b[i])
        u = _causal_dwconv(x @ w_up[i], ffn_conv_w[i]) + ffn_conv_b[i]
        val, gate = u[..., :D_FF], u[..., D_FF:]
        x = _layer_norm(ALPHA * x + (jax.nn.silu(gate) * val) @ w_down[i], ln2_g[i], ln2_b[i])
    return x
```

```cpp
#include <hip/hip_runtime.h>
#include <cstdio>
#include <cstdint>

constexpr int D_MODEL = 1024, BATCH = 8, SEQ = 4096, DEPTH = 2, HD = 64;
constexpr int MTOK = BATCH * SEQ;
constexpr int CONV_W = 512, NQH = 8, NG = 2, RPG = 4;
constexpr int IN_COLS = 2840, IN_PAD = 3072;
constexpr int D_FF = 2816, D_FF2 = 5632;
constexpr int NCMP = 255, NSEL = 64, TOPK = 16, WIN = 512;
constexpr float ALPHA = 1.41421356237309515f;
constexpr int CMP_K = 2048, CMP_H = 256;

typedef _Float16 h16;
typedef h16 h16x8 __attribute__((ext_vector_type(8)));
typedef h16 h16x4 __attribute__((ext_vector_type(4)));
typedef h16 h16x2 __attribute__((ext_vector_type(2)));
typedef short s16x8 __attribute__((ext_vector_type(8)));
typedef float f32x4 __attribute__((ext_vector_type(4)));
typedef float f32x2 __attribute__((ext_vector_type(2)));
typedef unsigned u32x4 __attribute__((ext_vector_type(4)));
typedef unsigned u32x2 __attribute__((ext_vector_type(2)));
#define LAS __attribute__((address_space(3)))

__device__ __forceinline__ unsigned pkh(float lo, float hi) { h16x2 v = {(h16)lo, (h16)hi}; return __builtin_bit_cast(unsigned, v); }

constexpr size_t MiB = 1u << 20;
constexpr size_t WS_ROPE = 1 * MiB;
constexpr size_t WS_CB1 = 1 * MiB + 512 * 1024;
constexpr size_t WS_WIN = 2 * MiB;
constexpr size_t WS_WOUT = 14 * MiB;
constexpr size_t WS_WUP = 18 * MiB;
constexpr size_t WS_WDN = 40 * MiB;
constexpr size_t WS_CW1 = 51 * MiB;
constexpr size_t WS_KCMP = 56 * MiB;
constexpr size_t WS_HCMP = 57 * MiB;
constexpr size_t WS_X16 = 64 * MiB;
constexpr size_t WS_P3 = 128 * MiB;
constexpr size_t WS_Q = 224 * MiB;
constexpr size_t WS_KV = 256 * MiB;
constexpr size_t WS_GATES = 304 * MiB;
constexpr size_t WS_MIXED = 306 * MiB;
constexpr size_t WS_U = 128 * MiB;
constexpr size_t WS_HID = 304 * MiB;
constexpr size_t WS_END = 400 * MiB;
constexpr size_t KV_CH = (size_t)MTOK * 64;

namespace pg8 {
constexpr int BM = 256, BK = 64, HALF = 128, HTB = HALF * BK * 2, STAGE_BYTES = 8 * HTB, NXCD = 8, WGM = 8;
__host__ __device__ __forceinline__ int lds_byte(int r, int c) { const int st = (r >> 4) * 2 + (c >> 5), rr = r & 15, cc = c & 31, ob = rr * 64 + cc * 2; return st * 1024 + (ob ^ (((ob >> 9) & 1) << 5)); }
__host__ __device__ __forceinline__ void stage_rc(int b, int& R, int& C) { const int st = b / 1024, sb = b % 1024, swz = sb ^ (((sb >> 9) & 1) << 5); R = (st >> 1) * 16 + swz / 64; C = (st & 1) * 32 + (swz % 64) / 2; }
__host__ __device__ __forceinline__ int perm32(int rho) { const int n = rho >> 4, i = rho & 15; return 8 * (i >> 2) + 4 * n + (i & 3); }

struct Unit { int pm, pn; };
struct Gemm { const h16* A; const h16* Bt; int lda, ldb, K; };

struct StaticOrder {
    int nM, nN, nwg, G, c;
    __host__ __device__ void init(int M, int N, int G_, int c_) { nM = M / BM; nN = N / BM; nwg = nM * nN; G = G_; c = c_; }
    __host__ __device__ bool next(int i, Unit& u) const {
        const long L = (long)i * G + c; if (L >= nwg) return false;
        int wgid = (int)L; { const int q = nwg / NXCD, r = nwg % NXCD, xcd = wgid % NXCD, off = wgid / NXCD; wgid = (xcd < r ? xcd * (q + 1) : r * (q + 1) + (xcd - r) * q) + off; }
        const int nig = WGM * nN, gid = wgid / nig, fm = gid * WGM, gsz = (nM - fm) < WGM ? (nM - fm) : WGM;
        u.pm = fm + ((wgid % nig) % gsz); u.pn = (wgid % nig) / gsz; return true;
    }
};
struct CmpOrder {
    int G, c;
    __host__ __device__ bool next(int i, Unit& u) const { const int L = i * G + c; if (L >= 32) return false; u.pm = L; u.pn = L >> 4; return true; }
};

template <class Epi, class Sched, bool ALIGN_EPI>
__device__ __forceinline__ void gemm_phase(LAS unsigned char* lds, const Gemm g, const Sched& S, const Epi& E) {
    const int tid = threadIdx.x, wid = __builtin_amdgcn_readfirstlane(tid >> 6), lane = tid & 63, wr = wid >> 2, wc = wid & 3, fr = lane & 15, fq = lane >> 4;
    const int K = g.K, nt = K / BK;
    unsigned voffA[2], voffB[2];
#pragma unroll
    for (int i = 0; i < 2; ++i) { int R, C; stage_rc(tid * 16 + i * 8192, R, C); const int Rb = Epi::PERM ? ((R & ~31) + perm32(R & 31)) : R;
        voffA[i] = (unsigned)(R * g.lda + C) * 2u; voffB[i] = (unsigned)(Rb * g.ldb + C) * 2u; }
    const size_t kstep = (size_t)(BK * 2);
    const size_t hstepA = (size_t)HALF * g.lda * 2, hstepB = (size_t)HALF * g.ldb * 2;
    const size_t tstepA = 2 * hstepA, tstepB = 2 * hstepB;
    const unsigned ldsw = (unsigned)wid * 1024u;
    const int aoff = lds_byte(wr * 64 + fr, fq * 8), boff = lds_byte(wc * 32 + fr, fq * 8);
#define PG8_SA(b, h) (((b) * 2 + (h)) * HTB)
#define PG8_SB(b, h) ((4 + (b) * 2 + (h)) * HTB)
#define PG8_STAGE(bufoff, gbase, voff) do { _Pragma("unroll") for (int _i = 0; _i < 2; ++_i) \
        __builtin_amdgcn_global_load_lds((const unsigned*)((const char*)(gbase) + (voff)[_i]), (LAS unsigned*)(lds + (bufoff) + ldsw + _i * 8192), 16, 0, 0); } while (0)
#define PG8_LDA(dst, b, h) do { _Pragma("unroll") for (int m = 0; m < 4; ++m) _Pragma("unroll") for (int k = 0; k < 2; ++k) dst[m][k] = *(const LAS h16x8*)(lds + PG8_SA(b, h) + aoff + m * 2048 + k * 1024); } while (0)
#define PG8_LDB(dst, b, h) do { _Pragma("unroll") for (int n = 0; n < 2; ++n) _Pragma("unroll") for (int k = 0; k < 2; ++k) dst[n][k] = *(const LAS h16x8*)(lds + PG8_SB(b, h) + boff + n * 2048 + k * 1024); } while (0)
#define PG8_MMA(ai, bj, At, Bt) do { __builtin_amdgcn_s_setprio(1); _Pragma("unroll") for (int m = 0; m < 4; ++m) _Pragma("unroll") for (int n = 0; n < 2; ++n) _Pragma("unroll") for (int k = 0; k < 2; ++k) \
        acc[ai][bj][m][n] = __builtin_amdgcn_mfma_f32_16x16x32_f16(Bt[n][k], At[m][k], acc[ai][bj][m][n], 0, 0, 0); __builtin_amdgcn_s_setprio(0); } while (0)
#define PG8_WAIT_V(n) asm volatile("s_waitcnt vmcnt(" #n ")" ::: "memory")
#define PG8_WAIT_L(n) asm volatile("s_waitcnt lgkmcnt(" #n ")" ::: "memory")
#define PG8_BAR __builtin_amdgcn_s_barrier()
#define PG8_SCHED __builtin_amdgcn_sched_barrier(0)
    Unit cur, nxt; int ui = 0;
    if (!S.next(0, cur)) return;
    f32x4 acc[2][2][4][2];
#pragma unroll
    for (int a = 0; a < 2; ++a)
#pragma unroll
        for (int b = 0; b < 2; ++b)
#pragma unroll
            for (int m = 0; m < 4; ++m)
#pragma unroll
                for (int n = 0; n < 2; ++n) acc[a][b][m][n] = (f32x4){0.f, 0.f, 0.f, 0.f};
    h16x8 At[4][2], B0[2][2], B1[2][2];
    const char* cA = (const char*)g.A + (size_t)cur.pm * tstepA; const char* cB = (const char*)g.Bt + (size_t)cur.pn * tstepB;
    PG8_STAGE(PG8_SB(0, 0), cB, voffB); PG8_STAGE(PG8_SB(0, 1), cB + hstepB, voffB); PG8_STAGE(PG8_SA(0, 0), cA, voffA); PG8_STAGE(PG8_SA(0, 1), cA + hstepA, voffA);
    if (wr == 1) PG8_BAR;
    PG8_WAIT_V(2); PG8_BAR;
    PG8_STAGE(PG8_SB(1, 0), cB + kstep, voffB); PG8_STAGE(PG8_SA(1, 0), cA + kstep, voffA); PG8_STAGE(PG8_SB(1, 1), cB + hstepB + kstep, voffB);
    PG8_WAIT_V(6); PG8_BAR;
    for (;;) {
        const bool has_next = S.next(ui + 1, nxt);
        const char* nA = has_next ? (const char*)g.A + (size_t)nxt.pm * tstepA : cA; const char* nB = has_next ? (const char*)g.Bt + (size_t)nxt.pn * tstepB : cB;
        for (int t = 0; t < nt; t += 2) {
            const bool last = (t == nt - 2);
            const char* a1 = cA + (size_t)(t + 1) * kstep;
            const char* a2 = last ? nA : cA + (size_t)(t + 2) * kstep; const char* b2 = last ? nB : cB + (size_t)(t + 2) * kstep;
            const char* a3 = a2 + kstep; const char* b3 = b2 + kstep;
            PG8_LDB(B0, 0, 0); PG8_LDB(B1, 0, 1); PG8_SCHED; PG8_LDA(At, 0, 0); PG8_STAGE(PG8_SA(1, 1), a1 + hstepA, voffA);
            PG8_WAIT_V(8); PG8_WAIT_L(0); PG8_BAR; PG8_MMA(0, 0, At, B0); PG8_MMA(0, 1, At, B1); PG8_BAR; PG8_SCHED;
            PG8_LDA(At, 0, 1); PG8_STAGE(PG8_SB(0, 0), b2, voffB); PG8_STAGE(PG8_SB(0, 1), b2 + hstepB, voffB); PG8_STAGE(PG8_SA(0, 0), a2, voffA);
            PG8_WAIT_V(8); PG8_WAIT_L(0); PG8_BAR; PG8_MMA(1, 0, At, B0); PG8_MMA(1, 1, At, B1); PG8_BAR; PG8_SCHED;
            PG8_LDB(B0, 1, 0); PG8_LDB(B1, 1, 1); PG8_SCHED; PG8_LDA(At, 1, 0); PG8_STAGE(PG8_SA(0, 1), a2 + hstepA, voffA);
            PG8_WAIT_V(8); PG8_WAIT_L(0); PG8_BAR; PG8_MMA(0, 0, At, B0); PG8_MMA(0, 1, At, B1); PG8_BAR; PG8_SCHED;
            PG8_LDA(At, 1, 1); PG8_STAGE(PG8_SB(1, 0), b3, voffB); PG8_STAGE(PG8_SB(1, 1), b3 + hstepB, voffB); PG8_STAGE(PG8_SA(1, 0), a3, voffA);
            PG8_WAIT_V(8); PG8_WAIT_L(0); PG8_BAR; PG8_MMA(1, 0, At, B0); PG8_MMA(1, 1, At, B1); PG8_BAR; PG8_SCHED;
        }
        if constexpr (ALIGN_EPI) { if (wr == 0) PG8_BAR; }
        E(acc, cur, wr, wc, fr, fq);
        if (!has_next) break;
#pragma unroll
        for (int a = 0; a < 2; ++a)
#pragma unroll
            for (int b = 0; b < 2; ++b)
#pragma unroll
                for (int m = 0; m < 4; ++m)
#pragma unroll
                    for (int n = 0; n < 2; ++n) acc[a][b][m][n] = (f32x4){0.f, 0.f, 0.f, 0.f};
        cur = nxt; cA = nA; cB = nB; ++ui;
        if constexpr (ALIGN_EPI) { if (wr == 1) PG8_BAR; }
    }
    PG8_WAIT_V(0);
    if constexpr (!ALIGN_EPI) { if (wr == 0) PG8_BAR; }
    PG8_BAR;
#undef PG8_SA
#undef PG8_SB
#undef PG8_STAGE
#undef PG8_LDA
#undef PG8_LDB
#undef PG8_MMA
#undef PG8_WAIT_V
#undef PG8_WAIT_L
#undef PG8_BAR
#undef PG8_SCHED
}

__device__ __forceinline__ u32x4 pack8(const f32x4 v0, const f32x4 v1) { u32x4 w; w.x = pkh(v0[0], v0[1]); w.y = pkh(v0[2], v0[3]); w.z = pkh(v1[0], v1[1]); w.w = pkh(v1[2], v1[3]); return w; }

struct EpiInProj {
    static constexpr bool PERM = true;
    h16 *P3, *Q, *KV, *GATES;
    __device__ __forceinline__ void operator()(const f32x4 (&acc)[2][2][4][2], const Unit& u, int wr, int wc, int fr, int fq) const {
        const int pn = u.pn; const int row0 = u.pm * BM + wr * 64 + fr;
#pragma unroll
        for (int ai = 0; ai < 2; ++ai)
#pragma unroll
            for (int m = 0; m < 4; ++m) { const size_t row = (size_t)(row0 + ai * HALF + m * 16);
#pragma unroll
                for (int bj = 0; bj < 2; ++bj) { const u32x4 w = pack8(acc[ai][bj][m][0], acc[ai][bj][m][1]);
                    if (pn < 6) *(u32x4*)(P3 + row * 1536 + pn * 256 + bj * 128 + wc * 32 + 8 * fq) = w;
                    else if (pn < 8) *(u32x4*)(Q + row * 512 + (pn - 6) * 256 + bj * 128 + wc * 32 + 8 * fq) = w;
                    else if (pn < 11) { const int ch = (pn - 8) * 4 + bj * 2 + (wc >> 1); *(u32x4*)(KV + (size_t)ch * KV_CH + row * 64 + (wc & 1) * 32 + 8 * fq) = w; }
                    else if (bj == 0 && wc == 0) *(u32x4*)(GATES + row * 32 + 8 * fq) = w; } }
    }
};
struct EpiH16 {
    static constexpr bool PERM = true;
    h16* O; int ldc;
    __device__ __forceinline__ void operator()(const f32x4 (&acc)[2][2][4][2], const Unit& u, int wr, int wc, int fr, int fq) const {
        const int row0 = u.pm * BM + wr * 64 + fr, col0 = u.pn * BM + wc * 32 + 8 * fq;
#pragma unroll
        for (int ai = 0; ai < 2; ++ai)
#pragma unroll
            for (int m = 0; m < 4; ++m) { h16* rowp = O + (size_t)(row0 + ai * HALF + m * 16) * ldc + col0;
#pragma unroll
                for (int bj = 0; bj < 2; ++bj) *(u32x4*)(rowp + bj * HALF) = pack8(acc[ai][bj][m][0], acc[ai][bj][m][1]); }
    }
};
struct EpiResid {
    static constexpr bool PERM = false;
    const float* res; float* out; int ldc;
    __device__ __forceinline__ void operator()(const f32x4 (&acc)[2][2][4][2], const Unit& u, int wr, int wc, int fr, int fq) const {
        const int row0 = u.pm * BM + wr * 64 + fr, col0 = u.pn * BM + wc * 32 + 4 * fq;
#pragma unroll
        for (int ai = 0; ai < 2; ++ai)
#pragma unroll
            for (int m = 0; m < 4; ++m) { const size_t off = (size_t)(row0 + ai * HALF + m * 16) * ldc + col0;
#pragma unroll
                for (int bj = 0; bj < 2; ++bj)
#pragma unroll
                    for (int n = 0; n < 2; ++n) { const f32x4 r = *(const f32x4*)(res + off + bj * HALF + n * 16); *(f32x4*)(out + off + bj * HALF + n * 16) = r * ALPHA + acc[ai][bj][m][n]; } }
    }
};
__device__ __forceinline__ float gelu_tanh(float x) {
    const float u = 0.7978845608028654f * (x + 0.044715f * x * x * x);
    const float e = __expf(2.0f * u);
    const float th = 1.0f - 2.0f / (e + 1.0f);
    return 0.5f * x * (1.0f + th);
}
struct EpiCmpH {
    static constexpr bool PERM = true;
    h16* H; const float* cb1;
    __device__ __forceinline__ void operator()(const f32x4 (&acc)[2][2][4][2], const Unit& u, int wr, int wc, int fr, int fq) const {
        const int row0 = u.pm * BM + wr * 64 + fr, col0 = wc * 32 + 8 * fq;
        f32x4 bv[2][2];
#pragma unroll
        for (int bj = 0; bj < 2; ++bj)
#pragma unroll
            for (int n = 0; n < 2; ++n) bv[bj][n] = *(const f32x4*)(cb1 + u.pn * 256 + col0 + bj * HALF + 4 * n);
#pragma unroll
        for (int ai = 0; ai < 2; ++ai)
#pragma unroll
            for (int m = 0; m < 4; ++m) { h16* rowp = H + (size_t)(row0 + ai * HALF + m * 16) * 256 + col0;
#pragma unroll
                for (int bj = 0; bj < 2; ++bj) { f32x4 v0 = acc[ai][bj][m][0] + bv[bj][0], v1 = acc[ai][bj][m][1] + bv[bj][1];
#pragma unroll
                    for (int e = 0; e < 4; ++e) { v0[e] = gelu_tanh(v0[e]); v1[e] = gelu_tanh(v1[e]); }
                    *(u32x4*)(rowp + bj * HALF) = pack8(v0, v1); } }
    }
};
}

constexpr int NTHR = 512, NWAVES = 8;
constexpr int GEMM_LDS = 131072 + 16384;

struct GemmArgs { const h16* A; const h16* Bt; int lda, ldb, K, M, N; void* p0; void* p1; void* p2; void* p3; int ldc; int pad; };

template <int EPI> __global__ void __launch_bounds__(NTHR, 2) k_gemm(GemmArgs a) {
    extern __shared__ __attribute__((aligned(16))) unsigned char lds[];
    LAS unsigned char* L = (LAS unsigned char*)lds;
    pg8::Gemm g{a.A, a.Bt, a.lda, a.ldb, a.K};
    if constexpr (EPI == 0) { pg8::StaticOrder S; S.init(a.M, a.N, gridDim.x, blockIdx.x); pg8::EpiInProj E{(h16*)a.p0, (h16*)a.p1, (h16*)a.p2, (h16*)a.p3}; pg8::gemm_phase<pg8::EpiInProj, pg8::StaticOrder, true>(L, g, S, E); }
    if constexpr (EPI == 1) { pg8::StaticOrder S; S.init(a.M, a.N, gridDim.x, blockIdx.x); pg8::EpiH16 E{(h16*)a.p0, a.ldc}; pg8::gemm_phase<pg8::EpiH16, pg8::StaticOrder, true>(L, g, S, E); }
    if constexpr (EPI == 2) { pg8::StaticOrder S; S.init(a.M, a.N, gridDim.x, blockIdx.x); pg8::EpiResid E{(const float*)a.p0, (float*)a.p1, a.ldc}; pg8::gemm_phase<pg8::EpiResid, pg8::StaticOrder, true>(L, g, S, E); }
    if constexpr (EPI == 3) { pg8::CmpOrder S{(int)gridDim.x, (int)blockIdx.x}; pg8::EpiCmpH E{(h16*)a.p0, (const float*)a.p1}; pg8::gemm_phase<pg8::EpiCmpH, pg8::CmpOrder, true>(L, g, S, E); }
}

__device__ __forceinline__ void transpose_item(const float* W, int K, int N, h16* WT, LAS float* scr, int item, int nblk, int lane) {
    const int kb = item / nblk, nb = item % nblk, k0 = 64 * kb, n0 = 32 * nb;
#pragma unroll 8
    for (int i = 0; i < 32; ++i) { const int kk = 2 * i + (lane >> 5); const int n = n0 + (lane & 31); scr[kk * 33 + (lane & 31)] = (n < N) ? W[(size_t)(k0 + kk) * N + n] : 0.f; }
    asm volatile("s_waitcnt lgkmcnt(0)" ::: "memory");
    const int c = lane & 7;
#pragma unroll
    for (int j = 0; j < 4; ++j) { const int n = (lane >> 3) + 8 * j; const LAS float* s = scr + (8 * c) * 33 + n;
        u32x4 o; o.x = pkh(s[0 * 33], s[1 * 33]); o.y = pkh(s[2 * 33], s[3 * 33]); o.z = pkh(s[4 * 33], s[5 * 33]); o.w = pkh(s[6 * 33], s[7 * 33]);
        *(u32x4*)(WT + (size_t)(n0 + n) * K + k0 + 8 * c) = o; }
    asm volatile("s_waitcnt lgkmcnt(0)" ::: "memory");
}
struct PrepArgs { const float* in[18]; unsigned char* ws; };
__global__ void __launch_bounds__(NTHR) k_prep(PrepArgs a) {
    __shared__ float scr_all[NWAVES * 64 * 33];
    const int tid = threadIdx.x, lane = tid & 63, wave = tid >> 6;
    LAS float* scr = (LAS float*)scr_all + wave * 64 * 33;
    const int gw = blockIdx.x * NWAVES + wave, NGW = gridDim.x * NWAVES;
    unsigned char* ws = a.ws;
    constexpr int I_IN = 16 * 96, I_OUT = 16 * 32, I_UP = 16 * 176, I_DN = 44 * 32, I_C1 = 32 * 8;
    constexpr int PER_L = I_IN + I_OUT + I_UP + I_DN + 2 * I_C1;
    for (int it = gw; it < DEPTH * PER_L; it += NGW) {
        const int l = it / PER_L; int r = it % PER_L;
        if (r < I_IN) { transpose_item(a.in[1] + (size_t)l * D_MODEL * IN_COLS, D_MODEL, IN_COLS, (h16*)(ws + WS_WIN) + (size_t)l * IN_PAD * D_MODEL, scr, r, 96, lane); continue; } r -= I_IN;
        if (r < I_OUT) { transpose_item(a.in[9] + (size_t)l * D_MODEL * D_MODEL, D_MODEL, D_MODEL, (h16*)(ws + WS_WOUT) + (size_t)l * D_MODEL * D_MODEL, scr, r, 32, lane); continue; } r -= I_OUT;
        if (r < I_UP) { transpose_item(a.in[12] + (size_t)l * D_MODEL * D_FF2, D_MODEL, D_FF2, (h16*)(ws + WS_WUP) + (size_t)l * D_FF2 * D_MODEL, scr, r, 176, lane); continue; } r -= I_UP;
        if (r < I_DN) { transpose_item(a.in[15] + (size_t)l * D_FF * D_MODEL, D_FF, D_MODEL, (h16*)(ws + WS_WDN) + (size_t)l * D_MODEL * D_FF, scr, r, 32, lane); continue; } r -= I_DN;
        const int kv = r / I_C1; r %= I_C1;
        transpose_item(a.in[4] + (size_t)(l * 2 + kv) * CMP_K * CMP_H, CMP_K, CMP_H, (h16*)(ws + WS_CW1) + (size_t)(l * 2 + kv) * CMP_H * CMP_K, scr, r, 8, lane);
    }
    const float* x = a.in[0]; h16* x16 = (h16*)(ws + WS_X16);
    for (int m = gw; m < MTOK; m += NGW) {
        const f32x4* xr = (const f32x4*)(x + (size_t)m * D_MODEL) + lane; u32x2* o = (u32x2*)(x16 + (size_t)m * D_MODEL) + lane;
#pragma unroll
        for (int j = 0; j < 4; ++j) { const f32x4 v = xr[64 * j]; u32x2 w; w.x = pkh(v[0], v[1]); w.y = pkh(v[2], v[3]); o[64 * j] = w; }
    }
    {
        float* rope = (float*)(ws + WS_ROPE);
        const int gt = blockIdx.x * NTHR + tid, NT = gridDim.x * NTHR;
        for (int i = gt; i < SEQ * 8; i += NT) { const int t = i >> 3, j = i & 7;
            const float inv = (float)pow(500000.0, -(double)j / 8.0);
            const float ang = (float)t * inv;
            rope[t * 16 + j] = (float)cos((double)ang); rope[t * 16 + 8 + j] = (float)sin((double)ang); }
        float* cb1 = (float*)(ws + WS_CB1);
        for (int i = gt; i < DEPTH * 2 * CMP_H; i += NT) { const int lk = i / CMP_H, n = i % CMP_H;
            const float* pe = a.in[3] + (size_t)lk * CMP_K; const float* w1 = a.in[4] + (size_t)lk * CMP_K * CMP_H;
            float s = a.in[5][i];
            for (int k = 0; k < CMP_K; ++k) s += pe[k] * w1[(size_t)k * CMP_H + n];
            cb1[i] = s; }
    }
}

__device__ __forceinline__ void ld8(const h16* p, float (&v)[8]) { const h16x8 h = *(const h16x8*)p;
#pragma unroll
    for (int i = 0; i < 8; ++i) v[i] = (float)h[i]; }
__global__ void __launch_bounds__(256) k_elem(unsigned char* ws, const float* convw  , const float* hng  ) {
    const int lane = threadIdx.x & 63, wave = threadIdx.x >> 6;
    const int gw = blockIdx.x * 4 + wave, NGW = gridDim.x * 4;
    const h16* P3 = (const h16*)(ws + WS_P3); h16* MIX = (h16*)(ws + WS_MIXED);
    h16* Q = (h16*)(ws + WS_Q); h16* KV = (h16*)(ws + WS_KV); const float* rope = (const float*)(ws + WS_ROPE);
    const int c0 = lane * 8;
    float w0[8], w1[8], w2[8], gg[8];
#pragma unroll
    for (int i = 0; i < 8; ++i) { w0[i] = convw[c0 + i]; w1[i] = convw[512 + c0 + i]; w2[i] = convw[1024 + c0 + i]; gg[i] = hng[c0 + i]; }
    for (int m = gw; m < MTOK; m += NGW) {
        const int t = m & (SEQ - 1);
        const h16* r0 = P3 + (size_t)m * 1536;
        float bg[8], z0[8], z1[8], z2[8], a_[8], b_[8];
        ld8(r0 + c0, bg);
        ld8(r0 + 512 + c0, a_); ld8(r0 + 1024 + c0, b_);
#pragma unroll
        for (int i = 0; i < 8; ++i) z2[i] = a_[i] * b_[i];
        if (t >= 1) { ld8(r0 - 1536 + 512 + c0, a_); ld8(r0 - 1536 + 1024 + c0, b_);
#pragma unroll
            for (int i = 0; i < 8; ++i) z1[i] = a_[i] * b_[i]; } else {
#pragma unroll
            for (int i = 0; i < 8; ++i) z1[i] = 0.f; }
        if (t >= 2) { ld8(r0 - 3072 + 512 + c0, a_); ld8(r0 - 3072 + 1024 + c0, b_);
#pragma unroll
            for (int i = 0; i < 8; ++i) z0[i] = a_[i] * b_[i]; } else {
#pragma unroll
            for (int i = 0; i < 8; ++i) z0[i] = 0.f; }
        float y[8]; float ss = 0.f;
#pragma unroll
        for (int i = 0; i < 8; ++i) { y[i] = bg[i] * (w0[i] * z0[i] + w1[i] * z1[i] + w2[i] * z2[i]); ss += y[i] * y[i]; }
        ss += __shfl_xor(ss, 1); ss += __shfl_xor(ss, 2); ss += __shfl_xor(ss, 4);
        const float rs = 1.0f / sqrtf(ss * (1.0f / 64.0f) + 1e-6f);
        u32x4 o; o.x = pkh(y[0] * rs * gg[0], y[1] * rs * gg[1]); o.y = pkh(y[2] * rs * gg[2], y[3] * rs * gg[3]); o.z = pkh(y[4] * rs * gg[4], y[5] * rs * gg[5]); o.w = pkh(y[6] * rs * gg[6], y[7] * rs * gg[7]);
        *(u32x4*)(MIX + (size_t)m * 1024 + c0) = o;
        if (lane < 14) {
            h16* p;
            if (lane < 8) p = Q + (size_t)m * 512 + lane * 64;
            else { const int k = lane - 8; const int ch = (k >> 1) * 4 + (k & 1); p = KV + (size_t)ch * KV_CH + (size_t)m * 64; }
            float x1[8], x2[8]; ld8(p, x1); ld8(p + 8, x2);
            const float* cs = rope + t * 16;
            float o1[8], o2[8];
#pragma unroll
            for (int j = 0; j < 8; ++j) { const float c = cs[j], s = cs[8 + j]; o1[j] = x1[j] * c - x2[j] * s; o2[j] = x2[j] * c + x1[j] * s; }
            u32x4 a; a.x = pkh(o1[0], o1[1]); a.y = pkh(o1[2], o1[3]); a.z = pkh(o1[4], o1[5]); a.w = pkh(o1[6], o1[7]);
            u32x4 b; b.x = pkh(o2[0], o2[1]); b.y = pkh(o2[2], o2[3]); b.z = pkh(o2[4], o2[5]); b.w = pkh(o2[6], o2[7]);
            *(u32x4*)p = a; *(u32x4*)(p + 8) = b;
        }
    }
}

__global__ void __launch_bounds__(256) k_cmp2(unsigned char* ws, const float* w2  , const float* b2  ) {
    const int lane = threadIdx.x & 63, wave = threadIdx.x >> 6;
    const int gw = blockIdx.x * 4 + wave, NGW = gridDim.x * 4;
    const h16* H = (const h16*)(ws + WS_HCMP); h16* KC = (h16*)(ws + WS_KCMP);
    for (int r = gw; r < 8192; r += NGW) {
        const int ch = r >> 11, b = (r >> 8) & 7, c = r & 255, kv = ch >> 1, g = ch & 1;
        float s = b2[kv * 64 + lane];
        const h16* hr = H + (size_t)r * 256; const float* w = w2 + (size_t)kv * 256 * 64 + lane;
        for (int j = 0; j < 256; ++j) s += (float)hr[j] * w[j * 64];
        if (c == 255) s = 0.f;
        KC[((size_t)((kv * BATCH + b) * NG + g) * 256 + c) * 64 + lane] = (h16)s;
    }
}

__device__ __forceinline__ float wmax(float v) {
#pragma unroll
    for (int o = 1; o < 64; o <<= 1) v = fmaxf(v, __shfl_xor(v, o)); return v; }
__device__ __forceinline__ float wsum(float v) {
#pragma unroll
    for (int o = 1; o < 64; o <<= 1) v += __shfl_xor(v, o); return v; }

__device__ __forceinline__ void dot4(const h16* krow, const float* qs, float (&s)[4]) {
    s[0] = s[1] = s[2] = s[3] = 0.f;
#pragma unroll
    for (int c8 = 0; c8 < 8; ++c8) { float kf[8]; ld8(krow + c8 * 8, kf);
#pragma unroll
        for (int i = 0; i < 8; ++i) { const int d = c8 * 8 + i; s[0] += kf[i] * qs[d]; s[1] += kf[i] * qs[64 + d]; s[2] += kf[i] * qs[128 + d]; s[3] += kf[i] * qs[192 + d]; } }
}

constexpr int ATT1_WAVES = 4;
constexpr int ATT1_LDS_PER_WAVE = (256 + 4 * 1024) * 4;
__global__ void __launch_bounds__(256) k_attn_v1(unsigned char* ws, const float* hng  ) {
    extern __shared__ __attribute__((aligned(16))) unsigned char lds[];
    const int lane = threadIdx.x & 63, wave = threadIdx.x >> 6;
    float* qs = (float*)(lds + wave * ATT1_LDS_PER_WAVE); float* ps = qs + 256;
    const h16* Q = (const h16*)(ws + WS_Q); const h16* KV = (const h16*)(ws + WS_KV); const h16* GT = (const h16*)(ws + WS_GATES);
    const h16* KCMP = (const h16*)(ws + WS_KCMP); h16* MIX = (h16*)(ws + WS_MIXED);
    const int NGW = gridDim.x * ATT1_WAVES;
    for (int id = blockIdx.x * ATT1_WAVES + wave; id < MTOK * NG; id += NGW) {
        const int m = id >> 1, g = id & 1, b = m >> 12, t = m & (SEQ - 1);
#pragma unroll
        for (int r = 0; r < 4; ++r) qs[r * 64 + lane] = (float)Q[(size_t)m * 512 + (g * 4 + r) * 64 + lane] * 0.125f;
        __builtin_amdgcn_wave_barrier();
        float oc[4], os[4], ow[4];
        const int nv = (t >= 31) ? min(NCMP, (t - 31) / 16 + 1) : 0;
        const h16* kc = KCMP + (size_t)((0 * BATCH + b) * NG + g) * 256 * 64;
        const h16* vc = KCMP + (size_t)((1 * BATCH + b) * NG + g) * 256 * 64;
        {
            float sc[4][4]; float mx[4] = {-1e30f, -1e30f, -1e30f, -1e30f};
#pragma unroll
            for (int i = 0; i < 4; ++i) { const int c = lane + 64 * i; float s[4];
                if (c < nv) dot4(kc + (size_t)c * 64, qs, s); else { s[0] = s[1] = s[2] = s[3] = -1e30f; }
#pragma unroll
                for (int r = 0; r < 4; ++r) { sc[r][i] = s[r]; mx[r] = fmaxf(mx[r], s[r]); } }
#pragma unroll
            for (int r = 0; r < 4; ++r) { const float M = wmax(mx[r]); float l = 0.f;
#pragma unroll
                for (int i = 0; i < 4; ++i) { const int c = lane + 64 * i; const float e = (c < nv) ? __expf(sc[r][i] - M) : 0.f; sc[r][i] = e; l += e; }
                l = wsum(l); const float il = (nv > 0) ? 1.0f / l : 0.f;
#pragma unroll
                for (int i = 0; i < 4; ++i) ps[r * 1024 + lane + 64 * i] = sc[r][i] * il; }
            __builtin_amdgcn_wave_barrier();
            oc[0] = oc[1] = oc[2] = oc[3] = 0.f;
            for (int c = 0; c < nv; ++c) { const float v = (float)vc[(size_t)c * 64 + lane];
#pragma unroll
                for (int r = 0; r < 4; ++r) oc[r] += ps[r * 1024 + c] * v; }
        }
        unsigned long long selmask;
        {
            const int s = lane; float imp = 0.f;
#pragma unroll
            for (int r = 0; r < 4; ++r) { const float* p = ps + r * 1024 + 4 * s;
                imp += p[0] + p[1] + p[2] + 0.5f * p[3] + (s > 0 ? 0.5f * p[-1] : 0.f); }
            const int tb = t >> 6;
            const bool forced = (s == 0) || (s == tb) || (s == tb - 1);
            float score = forced ? 1e9f : imp; if (s > tb) score = -1e9f;
            int rank = 0;
            for (int j = 0; j < 64; ++j) { const float o = __shfl(score, j); rank += (o > score || (o == score && j < s)) ? 1 : 0; }
            selmask = __ballot(rank < TOPK && s <= tb);
        }
        __builtin_amdgcn_wave_barrier();
        {
            const h16* ks = KV + (size_t)(4 + g) * KV_CH + (size_t)b * SEQ * 64; const h16* vs = KV + (size_t)(6 + g) * KV_CH + (size_t)b * SEQ * 64;
            float mx[4] = {-1e30f, -1e30f, -1e30f, -1e30f}; int nb = 0;
            for (unsigned long long mk = selmask; mk; mk &= mk - 1, ++nb) { const int blk = __builtin_ctzll(mk); const int key = blk * 64 + lane; float s[4];
                if (key <= t) dot4(ks + (size_t)key * 64, qs, s); else { s[0] = s[1] = s[2] = s[3] = -1e30f; }
#pragma unroll
                for (int r = 0; r < 4; ++r) { ps[r * 1024 + nb * 64 + lane] = s[r]; mx[r] = fmaxf(mx[r], s[r]); } }
            float il[4];
#pragma unroll
            for (int r = 0; r < 4; ++r) { const float M = wmax(mx[r]); float l = 0.f;
                for (int i = 0; i < nb; ++i) { const float sv = ps[r * 1024 + i * 64 + lane]; const float e = (sv > -1e29f) ? __expf(sv - M) : 0.f; ps[r * 1024 + i * 64 + lane] = e; l += e; }
                il[r] = 1.0f / wsum(l); }
            __builtin_amdgcn_wave_barrier();
            os[0] = os[1] = os[2] = os[3] = 0.f; int i = 0;
            for (unsigned long long mk = selmask; mk; mk &= mk - 1, ++i) { const int blk = __builtin_ctzll(mk); const int kmax = min(64, t - blk * 64 + 1);
                for (int j = 0; j < kmax; ++j) { const float v = (float)vs[(size_t)(blk * 64 + j) * 64 + lane];
#pragma unroll
                    for (int r = 0; r < 4; ++r) os[r] += ps[r * 1024 + i * 64 + j] * v; } }
#pragma unroll
            for (int r = 0; r < 4; ++r) os[r] *= il[r];
        }
        __builtin_amdgcn_wave_barrier();
        {
            const h16* kw = KV + (size_t)(8 + g) * KV_CH + (size_t)b * SEQ * 64; const h16* vw = KV + (size_t)(10 + g) * KV_CH + (size_t)b * SEQ * 64;
            const int k0 = max(0, t - (WIN - 1)), nk = t - k0 + 1, nb = (nk + 63) >> 6;
            float mx[4] = {-1e30f, -1e30f, -1e30f, -1e30f};
            for (int i = 0; i < nb; ++i) { const int key = k0 + i * 64 + lane; float s[4];
                if (key <= t) dot4(kw + (size_t)key * 64, qs, s); else { s[0] = s[1] = s[2] = s[3] = -1e30f; }
#pragma unroll
                for (int r = 0; r < 4; ++r) { ps[r * 1024 + i * 64 + lane] = s[r]; mx[r] = fmaxf(mx[r], s[r]); } }
            float il[4];
#pragma unroll
            for (int r = 0; r < 4; ++r) { const float M = wmax(mx[r]); float l = 0.f;
                for (int i = 0; i < nb; ++i) { const float sv = ps[r * 1024 + i * 64 + lane]; const float e = (sv > -1e29f) ? __expf(sv - M) : 0.f; ps[r * 1024 + i * 64 + lane] = e; l += e; }
                il[r] = 1.0f / wsum(l); }
            __builtin_amdgcn_wave_barrier();
            ow[0] = ow[1] = ow[2] = ow[3] = 0.f;
            for (int j = 0; j < nk; ++j) { const float v = (float)vw[(size_t)(k0 + j) * 64 + lane];
#pragma unroll
                for (int r = 0; r < 4; ++r) ow[r] += ps[r * 1024 + j] * v; }
#pragma unroll
            for (int r = 0; r < 4; ++r) ow[r] *= il[r];
        }
        __builtin_amdgcn_wave_barrier();
#pragma unroll
        for (int r = 0; r < 4; ++r) { const int hd = g * 4 + r; const h16* gp = GT + (size_t)m * 32 + hd * 3;
            const float g0 = 1.0f / (1.0f + __expf(-(float)gp[0])), g1 = 1.0f / (1.0f + __expf(-(float)gp[1])), g2 = 1.0f / (1.0f + __expf(-(float)gp[2]));
            const float o = g0 * oc[r] + g1 * os[r] + g2 * ow[r];
            const float ss = wsum(o * o); const float rs = 1.0f / sqrtf(ss * (1.0f / 64.0f) + 1e-6f);
            MIX[(size_t)m * 1024 + 512 + hd * 64 + lane] = (h16)(o * rs * hng[512 + hd * 64 + lane]); }
    }
}

__global__ void __launch_bounds__(256) k_ln(float* xio, h16* x16, const float* gam, const float* bet) {
    const int lane = threadIdx.x & 63, wave = threadIdx.x >> 6;
    const int gw = blockIdx.x * 4 + wave, NGW = gridDim.x * 4;
    f32x4 gv[4], bv[4];
#pragma unroll
    for (int j = 0; j < 4; ++j) { gv[j] = ((const f32x4*)gam)[lane + 64 * j]; bv[j] = ((const f32x4*)bet)[lane + 64 * j]; }
    for (int m = gw; m < MTOK; m += NGW) {
        f32x4* xr = (f32x4*)(xio + (size_t)m * D_MODEL) + lane;
        f32x4 v[4]; float s = 0.f;
#pragma unroll
        for (int j = 0; j < 4; ++j) { v[j] = xr[64 * j]; s += (v[j][0] + v[j][1]) + (v[j][2] + v[j][3]); }
        const float mean = wsum(s) * (1.0f / D_MODEL); float s2 = 0.f;
#pragma unroll
        for (int j = 0; j < 4; ++j) { v[j] = v[j] - mean; s2 += (v[j][0] * v[j][0] + v[j][1] * v[j][1]) + (v[j][2] * v[j][2] + v[j][3] * v[j][3]); }
        const float rstd = 1.0f / sqrtf(wsum(s2) * (1.0f / D_MODEL) + 1e-5f);
        u32x2* o16 = (u32x2*)(x16 + (size_t)m * D_MODEL) + lane;
#pragma unroll
        for (int j = 0; j < 4; ++j) { const f32x4 o = v[j] * rstd * gv[j] + bv[j]; xr[64 * j] = o; u32x2 w; w.x = pkh(o[0], o[1]); w.y = pkh(o[2], o[3]); o16[64 * j] = w; }
    }
}

__global__ void __launch_bounds__(256) k_ffnact(const h16* U, h16* HID, const float* cw  , const float* cb  , int nrows) {
    const int tid = blockIdx.x * 256 + threadIdx.x, NT = gridDim.x * 256;
    constexpr int CPR = D_FF / 8;
    for (int i = tid; i < nrows * CPR; i += NT) {
        const int m = i / CPR, c0 = (i % CPR) * 8, t = m & (SEQ - 1);
        float v[8], gt[8];
#pragma unroll
        for (int e = 0; e < 8; ++e) { v[e] = cb[c0 + e]; gt[e] = cb[D_FF + c0 + e]; }
#pragma unroll
        for (int k = 0; k < 3; ++k) { const int dt = 2 - k; if (t >= dt) { float a[8], b[8]; const h16* r = U + (size_t)(m - dt) * D_FF2; ld8(r + c0, a); ld8(r + D_FF + c0, b);
#pragma unroll
                for (int e = 0; e < 8; ++e) { v[e] += cw[k * D_FF2 + c0 + e] * a[e]; gt[e] += cw[k * D_FF2 + D_FF + c0 + e] * b[e]; } } }
        float o[8];
#pragma unroll
        for (int e = 0; e < 8; ++e) o[e] = gt[e] / (1.0f + __expf(-gt[e])) * v[e];
        u32x4 w; w.x = pkh(o[0], o[1]); w.y = pkh(o[2], o[3]); w.z = pkh(o[4], o[5]); w.w = pkh(o[6], o[7]);
        *(u32x4*)(HID + (size_t)m * D_FF + c0) = w;
    }
}

extern "C" void kernel_launch(void* const* d_in, const int* in_sizes, int n_in, void* d_out, int out_size, void* d_ws, size_t ws_size, hipStream_t stream) {
    static int inited = 0;
    if (!inited) {
        if (n_in != 18 || in_sizes[0] != MTOK * D_MODEL || out_size != MTOK * D_MODEL || ws_size < WS_END) { fprintf(stderr, "kernel_launch: unexpected shapes (n_in %d, ws %zu)\n", n_in, ws_size); inited = -1; return; }
        (void)hipFuncSetAttribute((const void*)k_gemm<0>, hipFuncAttributeMaxDynamicSharedMemorySize, GEMM_LDS);
        (void)hipFuncSetAttribute((const void*)k_gemm<1>, hipFuncAttributeMaxDynamicSharedMemorySize, GEMM_LDS);
        (void)hipFuncSetAttribute((const void*)k_gemm<2>, hipFuncAttributeMaxDynamicSharedMemorySize, GEMM_LDS);
        (void)hipFuncSetAttribute((const void*)k_gemm<3>, hipFuncAttributeMaxDynamicSharedMemorySize, GEMM_LDS);
        (void)hipFuncSetAttribute((const void*)k_attn_v1, hipFuncAttributeMaxDynamicSharedMemorySize, ATT1_WAVES * ATT1_LDS_PER_WAVE);
        inited = 1;
    }
    if (inited < 0) return;
    unsigned char* ws = (unsigned char*)d_ws; float* out = (float*)d_out;
    const float* const* in = (const float* const*)d_in;
    PrepArgs pa{}; for (int i = 0; i < 18; ++i) pa.in[i] = in[i]; pa.ws = ws;
    hipLaunchKernelGGL(k_prep, dim3(256), dim3(NTHR), 0, stream, pa);
    h16* X16 = (h16*)(ws + WS_X16);
    for (int l = 0; l < DEPTH; ++l) {
        { GemmArgs a{}; a.A = X16; a.Bt = (const h16*)(ws + WS_WIN) + (size_t)l * IN_PAD * D_MODEL; a.lda = D_MODEL; a.ldb = D_MODEL; a.K = D_MODEL; a.M = MTOK; a.N = IN_PAD;
          a.p0 = ws + WS_P3; a.p1 = ws + WS_Q; a.p2 = ws + WS_KV; a.p3 = ws + WS_GATES;
          hipLaunchKernelGGL(k_gemm<0>, dim3(256), dim3(NTHR), GEMM_LDS, stream, a); }
        hipLaunchKernelGGL(k_elem, dim3(2048), dim3(256), 0, stream, ws, in[2] + (size_t)l * 3 * CONV_W, in[8] + (size_t)l * 1024);
        { GemmArgs a{}; a.A = (const h16*)(ws + WS_KV); a.Bt = (const h16*)(ws + WS_CW1) + (size_t)l * 2 * CMP_H * CMP_K; a.lda = 1024; a.ldb = CMP_K; a.K = CMP_K; a.M = 8192; a.N = 512;
          a.p0 = ws + WS_HCMP; a.p1 = ws + WS_CB1 + (size_t)l * 2 * CMP_H * 4;
          hipLaunchKernelGGL(k_gemm<3>, dim3(256), dim3(NTHR), GEMM_LDS, stream, a); }
        hipLaunchKernelGGL(k_cmp2, dim3(512), dim3(256), 0, stream, ws, in[6] + (size_t)l * 2 * CMP_H * 64, in[7] + (size_t)l * 2 * 64);
        hipLaunchKernelGGL(k_attn_v1, dim3(2048), dim3(256), ATT1_WAVES * ATT1_LDS_PER_WAVE, stream, ws, in[8] + (size_t)l * 1024);
        { GemmArgs a{}; a.A = (const h16*)(ws + WS_MIXED); a.Bt = (const h16*)(ws + WS_WOUT) + (size_t)l * D_MODEL * D_MODEL; a.lda = D_MODEL; a.ldb = D_MODEL; a.K = D_MODEL; a.M = MTOK; a.N = D_MODEL;
          a.p0 = (void*)(l == 0 ? in[0] : out); a.p1 = out; a.ldc = D_MODEL;
          hipLaunchKernelGGL(k_gemm<2>, dim3(256), dim3(NTHR), GEMM_LDS, stream, a); }
        hipLaunchKernelGGL(k_ln, dim3(2048), dim3(256), 0, stream, out, X16, in[10] + (size_t)l * 1024, in[11] + (size_t)l * 1024);
        for (int hf = 0; hf < 2; ++hf) {
            const size_t r0 = (size_t)hf * (MTOK / 2);
            { GemmArgs a{}; a.A = X16 + r0 * D_MODEL; a.Bt = (const h16*)(ws + WS_WUP) + (size_t)l * D_FF2 * D_MODEL; a.lda = D_MODEL; a.ldb = D_MODEL; a.K = D_MODEL; a.M = MTOK / 2; a.N = D_FF2;
              a.p0 = ws + WS_U; a.ldc = D_FF2;
              hipLaunchKernelGGL(k_gemm<1>, dim3(256), dim3(NTHR), GEMM_LDS, stream, a); }
            hipLaunchKernelGGL(k_ffnact, dim3(2048), dim3(256), 0, stream, (const h16*)(ws + WS_U), (h16*)(ws + WS_HID), in[13] + (size_t)l * 3 * D_FF2, in[14] + (size_t)l * D_FF2, MTOK / 2);
            { GemmArgs a{}; a.A = (const h16*)(ws + WS_HID); a.Bt = (const h16*)(ws + WS_WDN) + (size_t)l * D_MODEL * D_FF; a.lda = D_FF; a.ldb = D_FF; a.K = D_FF; a.M = MTOK / 2; a.N = D_MODEL;
              a.p0 = out + r0 * D_MODEL; a.p1 = out + r0 * D_MODEL; a.ldc = D_MODEL;
              hipLaunchKernelGGL(k_gemm<2>, dim3(256), dim3(NTHR), GEMM_LDS, stream, a); }
        }
        hipLaunchKernelGGL(k_ln, dim3(2048), dim3(256), 0, stream, out, X16, in[16] + (size_t)l * 1024, in[17] + (size_t)l * 1024);
    }
}
```

```cpp
#include <hip/hip_runtime.h>
#include <hip/hip_cooperative_groups.h>
namespace cg = cooperative_groups;
#include <cstdio>
#include <cstdint>

constexpr int D_MODEL = 1024, BATCH = 8, SEQ = 4096, DEPTH = 2, HD = 64;
constexpr int MTOK = BATCH * SEQ;
constexpr int CONV_W = 512, NQH = 8, NG = 2, RPG = 4;
constexpr int IN_COLS = 2840, IN_PAD = 3072;
constexpr int D_FF = 2816, D_FF2 = 5632;
constexpr int NCMP = 255, NSEL = 64, TOPK = 16, WIN = 512;
constexpr float ALPHA = 1.41421356237309515f;
constexpr int CMP_K = 2048, CMP_H = 256;

typedef _Float16 h16;
typedef h16 h16x8 __attribute__((ext_vector_type(8)));
typedef h16 h16x4 __attribute__((ext_vector_type(4)));
typedef h16 h16x2 __attribute__((ext_vector_type(2)));
typedef short s16x8 __attribute__((ext_vector_type(8)));
typedef float f32x4 __attribute__((ext_vector_type(4)));
typedef float f32x2 __attribute__((ext_vector_type(2)));
typedef unsigned u32x4 __attribute__((ext_vector_type(4)));
typedef unsigned u32x2 __attribute__((ext_vector_type(2)));
#define LAS __attribute__((address_space(3)))

#define PHASE_IDS() int tid_ = threadIdx.x, bid_ = blockIdx.x, grd_ = gridDim.x; asm volatile("" : "+v"(tid_), "+s"(bid_), "+s"(grd_))
__device__ __forceinline__ unsigned pkh(float lo, float hi) { h16x2 v = {(h16)lo, (h16)hi}; return __builtin_bit_cast(unsigned, v); }

constexpr size_t MiB = 1u << 20;
constexpr size_t WS_ROPE = 1 * MiB;
constexpr size_t WS_CB1 = 1 * MiB + 512 * 1024;
constexpr size_t WS_WIN = 2 * MiB;
constexpr size_t WS_WOUT = 14 * MiB;
constexpr size_t WS_WUP = 18 * MiB;
constexpr size_t WS_WDN = 40 * MiB;
constexpr size_t WS_CW1 = 51 * MiB;
constexpr size_t WS_KCMP = 56 * MiB;
constexpr size_t WS_HCMP = 57 * MiB;
constexpr size_t WS_X16 = 64 * MiB;
constexpr size_t WS_P3 = 128 * MiB;
constexpr size_t WS_Q = 224 * MiB;
constexpr size_t WS_KV = 256 * MiB;
constexpr size_t WS_GATES = 304 * MiB;
constexpr size_t WS_MIXED = 306 * MiB;
constexpr size_t WS_U = 128 * MiB;
constexpr size_t WS_HID = 304 * MiB;
constexpr size_t WS_END = 400 * MiB;
constexpr size_t KV_CH = (size_t)MTOK * 64;

namespace pg8 {
constexpr int BM = 256, BK = 64, HALF = 128, HTB = HALF * BK * 2, STAGE_BYTES = 8 * HTB, NXCD = 8, WGM = 8;
__host__ __device__ __forceinline__ int lds_byte(int r, int c) { const int st = (r >> 4) * 2 + (c >> 5), rr = r & 15, cc = c & 31, ob = rr * 64 + cc * 2; return st * 1024 + (ob ^ (((ob >> 9) & 1) << 5)); }
__host__ __device__ __forceinline__ void stage_rc(int b, int& R, int& C) { const int st = b / 1024, sb = b % 1024, swz = sb ^ (((sb >> 9) & 1) << 5); R = (st >> 1) * 16 + swz / 64; C = (st & 1) * 32 + (swz % 64) / 2; }
__host__ __device__ __forceinline__ int perm32(int rho) { const int n = rho >> 4, i = rho & 15; return 8 * (i >> 2) + 4 * n + (i & 3); }

struct Unit { int pm, pn; };
struct Gemm { const h16* A; const h16* Bt; int lda, ldb, K; };

struct StaticOrder {
    int nM, nN, nwg, G, c;
    __host__ __device__ void init(int M, int N, int G_, int c_) { nM = M / BM; nN = N / BM; nwg = nM * nN; G = G_; c = c_; }
    __host__ __device__ bool next(int i, Unit& u) const {
        const long L = (long)i * G + c; if (L >= nwg) return false;
        int wgid = (int)L; { const int q = nwg / NXCD, r = nwg % NXCD, xcd = wgid % NXCD, off = wgid / NXCD; wgid = (xcd < r ? xcd * (q + 1) : r * (q + 1) + (xcd - r) * q) + off; }
        const int nig = WGM * nN, gid = wgid / nig, fm = gid * WGM, gsz = (nM - fm) < WGM ? (nM - fm) : WGM;
        u.pm = fm + ((wgid % nig) % gsz); u.pn = (wgid % nig) / gsz; return true;
    }
};
struct CmpOrder {
    int G, c;
    __host__ __device__ bool next(int i, Unit& u) const { const int L = i * G + c; if (L >= 32) return false; u.pm = L; u.pn = L >> 4; return true; }
};

template <class Epi, class Sched, bool ALIGN_EPI>
__device__ __forceinline__ void gemm_phase(LAS unsigned char* lds, const Gemm g, const Sched& S, const Epi& E) {
    int tid = threadIdx.x; asm volatile("" : "+v"(tid));
    const int wid = __builtin_amdgcn_readfirstlane(tid >> 6), lane = tid & 63, wr = wid >> 2, wc = wid & 3, fr = lane & 15, fq = lane >> 4;
    const int K = g.K, nt = K / BK;
    unsigned voffA[2], voffB[2];
#pragma unroll
    for (int i = 0; i < 2; ++i) { int R, C; stage_rc(tid * 16 + i * 8192, R, C); const int Rb = Epi::PERM ? ((R & ~31) + perm32(R & 31)) : R;
        voffA[i] = (unsigned)(R * g.lda + C) * 2u; voffB[i] = (unsigned)(Rb * g.ldb + C) * 2u; }
    const size_t kstep = (size_t)(BK * 2);
    const size_t hstepA = (size_t)HALF * g.lda * 2, hstepB = (size_t)HALF * g.ldb * 2;
    const size_t tstepA = 2 * hstepA, tstepB = 2 * hstepB;
    const unsigned ldsw = (unsigned)wid * 1024u;
    const int aoff = lds_byte(wr * 64 + fr, fq * 8), boff = lds_byte(wc * 32 + fr, fq * 8);
#define PG8_SA(b, h) (((b) * 2 + (h)) * HTB)
#define PG8_SB(b, h) ((4 + (b) * 2 + (h)) * HTB)
#define PG8_STAGE(bufoff, gbase, voff) do { _Pragma("unroll") for (int _i = 0; _i < 2; ++_i) \
        __builtin_amdgcn_global_load_lds((const unsigned*)((const char*)(gbase) + (voff)[_i]), (LAS unsigned*)(lds + (bufoff) + ldsw + _i * 8192), 16, 0, 0); } while (0)
#define PG8_LDA(dst, b, h) do { _Pragma("unroll") for (int m = 0; m < 4; ++m) _Pragma("unroll") for (int k = 0; k < 2; ++k) dst[m][k] = *(const LAS h16x8*)(lds + PG8_SA(b, h) + aoff + m * 2048 + k * 1024); } while (0)
#define PG8_LDB(dst, b, h) do { _Pragma("unroll") for (int n = 0; n < 2; ++n) _Pragma("unroll") for (int k = 0; k < 2; ++k) dst[n][k] = *(const LAS h16x8*)(lds + PG8_SB(b, h) + boff + n * 2048 + k * 1024); } while (0)
#define PG8_MMA(ai, bj, At, Bt) do { __builtin_amdgcn_s_setprio(1); _Pragma("unroll") for (int m = 0; m < 4; ++m) _Pragma("unroll") for (int n = 0; n < 2; ++n) _Pragma("unroll") for (int k = 0; k < 2; ++k) \
        acc[ai][bj][m][n] = __builtin_amdgcn_mfma_f32_16x16x32_f16(Bt[n][k], At[m][k], acc[ai][bj][m][n], 0, 0, 0); __builtin_amdgcn_s_setprio(0); } while (0)
#define PG8_WAIT_V(n) asm volatile("s_waitcnt vmcnt(" #n ")" ::: "memory")
#define PG8_WAIT_L(n) asm volatile("s_waitcnt lgkmcnt(" #n ")" ::: "memory")
#define PG8_BAR __builtin_amdgcn_s_barrier()
#define PG8_SCHED __builtin_amdgcn_sched_barrier(0)
    Unit cur, nxt; int ui = 0;
    if (!S.next(0, cur)) return;
    f32x4 acc[2][2][4][2];
#pragma unroll
    for (int a = 0; a < 2; ++a)
#pragma unroll
        for (int b = 0; b < 2; ++b)
#pragma unroll
            for (int m = 0; m < 4; ++m)
#pragma unroll
                for (int n = 0; n < 2; ++n) acc[a][b][m][n] = (f32x4){0.f, 0.f, 0.f, 0.f};
    h16x8 At[4][2], B0[2][2], B1[2][2];
    const char* cA = (const char*)g.A + (size_t)cur.pm * tstepA; const char* cB = (const char*)g.Bt + (size_t)cur.pn * tstepB;
    PG8_STAGE(PG8_SB(0, 0), cB, voffB); PG8_STAGE(PG8_SB(0, 1), cB + hstepB, voffB); PG8_STAGE(PG8_SA(0, 0), cA, voffA); PG8_STAGE(PG8_SA(0, 1), cA + hstepA, voffA);
    if (wr == 1) PG8_BAR;
    PG8_WAIT_V(2); PG8_BAR;
    PG8_STAGE(PG8_SB(1, 0), cB + kstep, voffB); PG8_STAGE(PG8_SA(1, 0), cA + kstep, voffA); PG8_STAGE(PG8_SB(1, 1), cB + hstepB + kstep, voffB);
    PG8_WAIT_V(6); PG8_BAR;
    for (;;) {
        const bool has_next = S.next(ui + 1, nxt);
        const char* nA = has_next ? (const char*)g.A + (size_t)nxt.pm * tstepA : cA; const char* nB = has_next ? (const char*)g.Bt + (size_t)nxt.pn * tstepB : cB;
        for (int t = 0; t < nt; t += 2) {
            const bool last = (t == nt - 2);
            const char* a1 = cA + (size_t)(t + 1) * kstep;
            const char* a2 = last ? nA : cA + (size_t)(t + 2) * kstep; const char* b2 = last ? nB : cB + (size_t)(t + 2) * kstep;
            const char* a3 = a2 + kstep; const char* b3 = b2 + kstep;
            PG8_LDB(B0, 0, 0); PG8_LDB(B1, 0, 1); PG8_SCHED; PG8_LDA(At, 0, 0); PG8_STAGE(PG8_SA(1, 1), a1 + hstepA, voffA);
            PG8_WAIT_V(8); PG8_WAIT_L(0); PG8_BAR; PG8_MMA(0, 0, At, B0); PG8_MMA(0, 1, At, B1); PG8_BAR; PG8_SCHED;
            PG8_LDA(At, 0, 1); PG8_STAGE(PG8_SB(0, 0), b2, voffB); PG8_STAGE(PG8_SB(0, 1), b2 + hstepB, voffB); PG8_STAGE(PG8_SA(0, 0), a2, voffA);
            PG8_WAIT_V(8); PG8_WAIT_L(0); PG8_BAR; PG8_MMA(1, 0, At, B0); PG8_MMA(1, 1, At, B1); PG8_BAR; PG8_SCHED;
            PG8_LDB(B0, 1, 0); PG8_LDB(B1, 1, 1); PG8_SCHED; PG8_LDA(At, 1, 0); PG8_STAGE(PG8_SA(0, 1), a2 + hstepA, voffA);
            PG8_WAIT_V(8); PG8_WAIT_L(0); PG8_BAR; PG8_MMA(0, 0, At, B0); PG8_MMA(0, 1, At, B1); PG8_BAR; PG8_SCHED;
            PG8_LDA(At, 1, 1); PG8_STAGE(PG8_SB(1, 0), b3, voffB); PG8_STAGE(PG8_SB(1, 1), b3 + hstepB, voffB); PG8_STAGE(PG8_SA(1, 0), a3, voffA);
            PG8_WAIT_V(8); PG8_WAIT_L(0); PG8_BAR; PG8_MMA(1, 0, At, B0); PG8_MMA(1, 1, At, B1); PG8_BAR; PG8_SCHED;
        }
        if constexpr (ALIGN_EPI) { if (wr == 0) PG8_BAR; }
        E(acc, cur, wr, wc, fr, fq);
        if (!has_next) break;
#pragma unroll
        for (int a = 0; a < 2; ++a)
#pragma unroll
            for (int b = 0; b < 2; ++b)
#pragma unroll
                for (int m = 0; m < 4; ++m)
#pragma unroll
                    for (int n = 0; n < 2; ++n) acc[a][b][m][n] = (f32x4){0.f, 0.f, 0.f, 0.f};
        cur = nxt; cA = nA; cB = nB; ++ui;
        if constexpr (ALIGN_EPI) { if (wr == 1) PG8_BAR; }
    }
    PG8_WAIT_V(0);
    if constexpr (!ALIGN_EPI) { if (wr == 0) PG8_BAR; }
    PG8_BAR;
#undef PG8_SA
#undef PG8_SB
#undef PG8_STAGE
#undef PG8_LDA
#undef PG8_LDB
#undef PG8_MMA
#undef PG8_WAIT_V
#undef PG8_WAIT_L
#undef PG8_BAR
#undef PG8_SCHED
}

__device__ __forceinline__ u32x4 pack8(const f32x4 v0, const f32x4 v1) { u32x4 w; w.x = pkh(v0[0], v0[1]); w.y = pkh(v0[2], v0[3]); w.z = pkh(v1[0], v1[1]); w.w = pkh(v1[2], v1[3]); return w; }

struct EpiInProj {
    static constexpr bool PERM = true;
    h16 *P3, *Q, *KV, *GATES;
    __device__ __forceinline__ void operator()(const f32x4 (&acc)[2][2][4][2], const Unit& u, int wr, int wc, int fr, int fq) const {
        const int pn = u.pn; const int row0 = u.pm * BM + wr * 64 + fr;
#pragma unroll
        for (int ai = 0; ai < 2; ++ai)
#pragma unroll
            for (int m = 0; m < 4; ++m) { const size_t row = (size_t)(row0 + ai * HALF + m * 16);
#pragma unroll
                for (int bj = 0; bj < 2; ++bj) { const u32x4 w = pack8(acc[ai][bj][m][0], acc[ai][bj][m][1]);
                    if (pn < 6) *(u32x4*)(P3 + row * 1536 + pn * 256 + bj * 128 + wc * 32 + 8 * fq) = w;
                    else if (pn < 8) *(u32x4*)(Q + row * 512 + (pn - 6) * 256 + bj * 128 + wc * 32 + 8 * fq) = w;
                    else if (pn < 11) { const int ch = (pn - 8) * 4 + bj * 2 + (wc >> 1); *(u32x4*)(KV + (size_t)ch * KV_CH + row * 64 + (wc & 1) * 32 + 8 * fq) = w; }
                    else if (bj == 0 && wc == 0) *(u32x4*)(GATES + row * 32 + 8 * fq) = w; } }
    }
};
struct EpiH16 {
    static constexpr bool PERM = true;
    h16* O; int ldc;
    __device__ __forceinline__ void operator()(const f32x4 (&acc)[2][2][4][2], const Unit& u, int wr, int wc, int fr, int fq) const {
        const int row0 = u.pm * BM + wr * 64 + fr, col0 = u.pn * BM + wc * 32 + 8 * fq;
#pragma unroll
        for (int ai = 0; ai < 2; ++ai)
#pragma unroll
            for (int m = 0; m < 4; ++m) { h16* rowp = O + (size_t)(row0 + ai * HALF + m * 16) * ldc + col0;
#pragma unroll
                for (int bj = 0; bj < 2; ++bj) *(u32x4*)(rowp + bj * HALF) = pack8(acc[ai][bj][m][0], acc[ai][bj][m][1]); }
    }
};
struct EpiResid {
    static constexpr bool PERM = false;
    const float* res; float* out; int ldc;
    __device__ __forceinline__ void operator()(const f32x4 (&acc)[2][2][4][2], const Unit& u, int wr, int wc, int fr, int fq) const {
        const int row0 = u.pm * BM + wr * 64 + fr, col0 = u.pn * BM + wc * 32 + 4 * fq;
#pragma unroll
        for (int ai = 0; ai < 2; ++ai)
#pragma unroll
            for (int m = 0; m < 4; ++m) { const size_t off = (size_t)(row0 + ai * HALF + m * 16) * ldc + col0;
#pragma unroll
                for (int bj = 0; bj < 2; ++bj)
#pragma unroll
                    for (int n = 0; n < 2; ++n) { const f32x4 r = *(const f32x4*)(res + off + bj * HALF + n * 16); *(f32x4*)(out + off + bj * HALF + n * 16) = r * ALPHA + acc[ai][bj][m][n]; } }
    }
};
__device__ __forceinline__ float gelu_tanh(float x) {
    const float u = 0.7978845608028654f * (x + 0.044715f * x * x * x);
    const float e = __expf(2.0f * u);
    const float th = 1.0f - 2.0f / (e + 1.0f);
    return 0.5f * x * (1.0f + th);
}
struct EpiCmpH {
    static constexpr bool PERM = true;
    h16* H; const float* cb1;
    __device__ __forceinline__ void operator()(const f32x4 (&acc)[2][2][4][2], const Unit& u, int wr, int wc, int fr, int fq) const {
        const int row0 = u.pm * BM + wr * 64 + fr, col0 = wc * 32 + 8 * fq;
        f32x4 bv[2][2];
#pragma unroll
        for (int bj = 0; bj < 2; ++bj)
#pragma unroll
            for (int n = 0; n < 2; ++n) bv[bj][n] = *(const f32x4*)(cb1 + u.pn * 256 + col0 + bj * HALF + 4 * n);
#pragma unroll
        for (int ai = 0; ai < 2; ++ai)
#pragma unroll
            for (int m = 0; m < 4; ++m) { h16* rowp = H + (size_t)(row0 + ai * HALF + m * 16) * 256 + col0;
#pragma unroll
                for (int bj = 0; bj < 2; ++bj) { f32x4 v0 = acc[ai][bj][m][0] + bv[bj][0], v1 = acc[ai][bj][m][1] + bv[bj][1];
#pragma unroll
                    for (int e = 0; e < 4; ++e) { v0[e] = gelu_tanh(v0[e]); v1[e] = gelu_tanh(v1[e]); }
                    *(u32x4*)(rowp + bj * HALF) = pack8(v0, v1); } }
    }
};
}

constexpr int NTHR = 512, NWAVES = 8;
constexpr int GEMM_LDS = 131072 + 16384;

__device__ __forceinline__ void transpose_item(const float* W, int K, int N, h16* WT, LAS float* scr, int item, int nblk, int lane) {
    const int kb = item / nblk, nb = item % nblk, k0 = 64 * kb, n0 = 32 * nb;
#pragma unroll 8
    for (int i = 0; i < 32; ++i) { const int kk = 2 * i + (lane >> 5); const int n = n0 + (lane & 31); scr[kk * 33 + (lane & 31)] = (n < N) ? W[(size_t)(k0 + kk) * N + n] : 0.f; }
    asm volatile("s_waitcnt lgkmcnt(0)" ::: "memory");
    const int c = lane & 7;
#pragma unroll
    for (int j = 0; j < 4; ++j) { const int n = (lane >> 3) + 8 * j; const LAS float* s = scr + (8 * c) * 33 + n;
        u32x4 o; o.x = pkh(s[0 * 33], s[1 * 33]); o.y = pkh(s[2 * 33], s[3 * 33]); o.z = pkh(s[4 * 33], s[5 * 33]); o.w = pkh(s[6 * 33], s[7 * 33]);
        *(u32x4*)(WT + (size_t)(n0 + n) * K + k0 + 8 * c) = o; }
    asm volatile("s_waitcnt lgkmcnt(0)" ::: "memory");
}
struct MegaArgs { const float* in[18]; float* out; unsigned char* ws; };
typedef const __attribute__((address_space(4))) MegaArgs* KArgs;
__device__ __forceinline__ void prep_phase(KArgs ap, LAS unsigned char* lds) {
#define a (*ap)
    PHASE_IDS(); const int tid = tid_, lane = tid & 63, wave = tid >> 6;
    LAS float* scr = (LAS float*)lds + wave * 64 * 33;
    const int gw = bid_ * NWAVES + wave, NGW = grd_ * NWAVES;
    unsigned char* ws = a.ws;
    constexpr int I_IN = 16 * 96, I_OUT = 16 * 32, I_UP = 16 * 176, I_DN = 44 * 32, I_C1 = 32 * 8;
    constexpr int PER_L = I_IN + I_OUT + I_UP + I_DN + 2 * I_C1;
    for (int it = gw; it < DEPTH * PER_L; it += NGW) {
        const int l = it / PER_L; int r = it % PER_L;
        if (r < I_IN) { transpose_item(a.in[1] + (size_t)l * D_MODEL * IN_COLS, D_MODEL, IN_COLS, (h16*)(ws + WS_WIN) + (size_t)l * IN_PAD * D_MODEL, scr, r, 96, lane); continue; } r -= I_IN;
        if (r < I_OUT) { transpose_item(a.in[9] + (size_t)l * D_MODEL * D_MODEL, D_MODEL, D_MODEL, (h16*)(ws + WS_WOUT) + (size_t)l * D_MODEL * D_MODEL, scr, r, 32, lane); continue; } r -= I_OUT;
        if (r < I_UP) { transpose_item(a.in[12] + (size_t)l * D_MODEL * D_FF2, D_MODEL, D_FF2, (h16*)(ws + WS_WUP) + (size_t)l * D_FF2 * D_MODEL, scr, r, 176, lane); continue; } r -= I_UP;
        if (r < I_DN) { transpose_item(a.in[15] + (size_t)l * D_FF * D_MODEL, D_FF, D_MODEL, (h16*)(ws + WS_WDN) + (size_t)l * D_MODEL * D_FF, scr, r, 32, lane); continue; } r -= I_DN;
        const int kv = r / I_C1; r %= I_C1;
        transpose_item(a.in[4] + (size_t)(l * 2 + kv) * CMP_K * CMP_H, CMP_K, CMP_H, (h16*)(ws + WS_CW1) + (size_t)(l * 2 + kv) * CMP_H * CMP_K, scr, r, 8, lane);
    }
    const float* x = a.in[0]; h16* x16 = (h16*)(ws + WS_X16);
    for (int m = gw; m < MTOK; m += NGW) {
        const f32x4* xr = (const f32x4*)(x + (size_t)m * D_MODEL) + lane; u32x2* o = (u32x2*)(x16 + (size_t)m * D_MODEL) + lane;
#pragma unroll
        for (int j = 0; j < 4; ++j) { const f32x4 v = xr[64 * j]; u32x2 w; w.x = pkh(v[0], v[1]); w.y = pkh(v[2], v[3]); o[64 * j] = w; }
    }
    {
        float* rope = (float*)(ws + WS_ROPE);
        const int gt = bid_ * NTHR + tid, NT = grd_ * NTHR;
        for (int i = gt; i < SEQ * 8; i += NT) { const int t = i >> 3, j = i & 7;
            const float inv = (float)pow(500000.0, -(double)j / 8.0);
            const float ang = (float)t * inv;
            rope[t * 16 + j] = (float)cos((double)ang); rope[t * 16 + 8 + j] = (float)sin((double)ang); }
        float* cb1 = (float*)(ws + WS_CB1);
        for (int i = gt; i < DEPTH * 2 * CMP_H; i += NT) { const int lk = i / CMP_H, n = i % CMP_H;
            const float* pe = a.in[3] + (size_t)lk * CMP_K; const float* w1 = a.in[4] + (size_t)lk * CMP_K * CMP_H;
            float s = a.in[5][i];
            for (int k = 0; k < CMP_K; ++k) s += pe[k] * w1[(size_t)k * CMP_H + n];
            cb1[i] = s; }
    }
#undef a
}

__device__ __forceinline__ void ld8(const h16* p, float (&v)[8]) { const h16x8 h = *(const h16x8*)p;
#pragma unroll
    for (int i = 0; i < 8; ++i) v[i] = (float)h[i]; }
__device__ __forceinline__ void elem_phase(unsigned char* ws, const float* convw  , const float* hng  ) {
    PHASE_IDS(); const int lane = tid_ & 63, wave = tid_ >> 6;
    const int gw = bid_ * NWAVES + wave, NGW = grd_ * NWAVES;
    const h16* P3 = (const h16*)(ws + WS_P3); h16* MIX = (h16*)(ws + WS_MIXED);
    h16* Q = (h16*)(ws + WS_Q); h16* KV = (h16*)(ws + WS_KV); const float* rope = (const float*)(ws + WS_ROPE);
    const int c0 = lane * 8;
    float w0[8], w1[8], w2[8], gg[8];
#pragma unroll
    for (int i = 0; i < 8; ++i) { w0[i] = convw[c0 + i]; w1[i] = convw[512 + c0 + i]; w2[i] = convw[1024 + c0 + i]; gg[i] = hng[c0 + i]; }
    for (int m = gw; m < MTOK; m += NGW) {
        const int t = m & (SEQ - 1);
        const h16* r0 = P3 + (size_t)m * 1536;
        float bg[8], z0[8], z1[8], z2[8], a_[8], b_[8];
        ld8(r0 + c0, bg);
        ld8(r0 + 512 + c0, a_); ld8(r0 + 1024 + c0, b_);
#pragma unroll
        for (int i = 0; i < 8; ++i) z2[i] = a_[i] * b_[i];
        if (t >= 1) { ld8(r0 - 1536 + 512 + c0, a_); ld8(r0 - 1536 + 1024 + c0, b_);
#pragma unroll
            for (int i = 0; i < 8; ++i) z1[i] = a_[i] * b_[i]; } else {
#pragma unroll
            for (int i = 0; i < 8; ++i) z1[i] = 0.f; }
        if (t >= 2) { ld8(r0 - 3072 + 512 + c0, a_); ld8(r0 - 3072 + 1024 + c0, b_);
#pragma unroll
            for (int i = 0; i < 8; ++i) z0[i] = a_[i] * b_[i]; } else {
#pragma unroll
            for (int i = 0; i < 8; ++i) z0[i] = 0.f; }
        float y[8]; float ss = 0.f;
#pragma unroll
        for (int i = 0; i < 8; ++i) { y[i] = bg[i] * (w0[i] * z0[i] + w1[i] * z1[i] + w2[i] * z2[i]); ss += y[i] * y[i]; }
        ss += __shfl_xor(ss, 1); ss += __shfl_xor(ss, 2); ss += __shfl_xor(ss, 4);
        const float rs = 1.0f / sqrtf(ss * (1.0f / 64.0f) + 1e-6f);
        u32x4 o; o.x = pkh(y[0] * rs * gg[0], y[1] * rs * gg[1]); o.y = pkh(y[2] * rs * gg[2], y[3] * rs * gg[3]); o.z = pkh(y[4] * rs * gg[4], y[5] * rs * gg[5]); o.w = pkh(y[6] * rs * gg[6], y[7] * rs * gg[7]);
        *(u32x4*)(MIX + (size_t)m * 1024 + c0) = o;
        if (lane < 14) {
            h16* p;
            if (lane < 8) p = Q + (size_t)m * 512 + lane * 64;
            else { const int k = lane - 8; const int ch = (k >> 1) * 4 + (k & 1); p = KV + (size_t)ch * KV_CH + (size_t)m * 64; }
            float x1[8], x2[8]; ld8(p, x1); ld8(p + 8, x2);
            const float* cs = rope + t * 16;
            float o1[8], o2[8];
#pragma unroll
            for (int j = 0; j < 8; ++j) { const float c = cs[j], s = cs[8 + j]; o1[j] = x1[j] * c - x2[j] * s; o2[j] = x2[j] * c + x1[j] * s; }
            u32x4 a; a.x = pkh(o1[0], o1[1]); a.y = pkh(o1[2], o1[3]); a.z = pkh(o1[4], o1[5]); a.w = pkh(o1[6], o1[7]);
            u32x4 b; b.x = pkh(o2[0], o2[1]); b.y = pkh(o2[2], o2[3]); b.z = pkh(o2[4], o2[5]); b.w = pkh(o2[6], o2[7]);
            *(u32x4*)p = a; *(u32x4*)(p + 8) = b;
        }
    }
}

__device__ __forceinline__ void cmp2_phase(unsigned char* ws, const float* w2  , const float* b2  ) {
    PHASE_IDS(); const int lane = tid_ & 63, wave = tid_ >> 6;
    const int gw = bid_ * NWAVES + wave, NGW = grd_ * NWAVES;
    const h16* H = (const h16*)(ws + WS_HCMP); h16* KC = (h16*)(ws + WS_KCMP);
    for (int r = gw; r < 8192; r += NGW) {
        const int ch = r >> 11, b = (r >> 8) & 7, c = r & 255, kv = ch >> 1, g = ch & 1;
        float s = b2[kv * 64 + lane];
        const h16* hr = H + (size_t)r * 256; const float* w = w2 + (size_t)kv * 256 * 64 + lane;
        for (int j = 0; j < 256; ++j) s += (float)hr[j] * w[j * 64];
        if (c == 255) s = 0.f;
        KC[((size_t)((kv * BATCH + b) * NG + g) * 256 + c) * 64 + lane] = (h16)s;
    }
}

__device__ __forceinline__ float wmax(float v) {
#pragma unroll
    for (int o = 1; o < 64; o <<= 1) v = fmaxf(v, __shfl_xor(v, o)); return v; }
__device__ __forceinline__ float wsum(float v) {
#pragma unroll
    for (int o = 1; o < 64; o <<= 1) v += __shfl_xor(v, o); return v; }

__device__ __forceinline__ void dot4(const h16* krow, const LAS float* qs, float (&s)[4]) {
    s[0] = s[1] = s[2] = s[3] = 0.f;
#pragma unroll
    for (int c8 = 0; c8 < 8; ++c8) { float kf[8]; ld8(krow + c8 * 8, kf);
#pragma unroll
        for (int i = 0; i < 8; ++i) { const int d = c8 * 8 + i; s[0] += kf[i] * qs[d]; s[1] += kf[i] * qs[64 + d]; s[2] += kf[i] * qs[128 + d]; s[3] += kf[i] * qs[192 + d]; } }
}

constexpr int ATT1_WAVES = NWAVES;
constexpr int ATT1_LDS_PER_WAVE = (256 + 4 * 1024) * 4;
__device__ __forceinline__ void attn_v1_phase(unsigned char* ws, const float* hng  , LAS unsigned char* lds) {
    PHASE_IDS(); const int lane = tid_ & 63, wave = tid_ >> 6;
    LAS float* qs = (LAS float*)(lds + wave * ATT1_LDS_PER_WAVE); LAS float* ps = qs + 256;
    const h16* Q = (const h16*)(ws + WS_Q); const h16* KV = (const h16*)(ws + WS_KV); const h16* GT = (const h16*)(ws + WS_GATES);
    const h16* KCMP = (const h16*)(ws + WS_KCMP); h16* MIX = (h16*)(ws + WS_MIXED);
    const int NGW = grd_ * ATT1_WAVES;
    for (int id = bid_ * ATT1_WAVES + wave; id < MTOK * NG; id += NGW) {
        const int m = id >> 1, g = id & 1, b = m >> 12, t = m & (SEQ - 1);
#pragma unroll
        for (int r = 0; r < 4; ++r) qs[r * 64 + lane] = (float)Q[(size_t)m * 512 + (g * 4 + r) * 64 + lane] * 0.125f;
        __builtin_amdgcn_wave_barrier();
        float oc[4], os[4], ow[4];
        const int nv = (t >= 31) ? min(NCMP, (t - 31) / 16 + 1) : 0;
        const h16* kc = KCMP + (size_t)((0 * BATCH + b) * NG + g) * 256 * 64;
        const h16* vc = KCMP + (size_t)((1 * BATCH + b) * NG + g) * 256 * 64;
        {
            float sc[4][4]; float mx[4] = {-1e30f, -1e30f, -1e30f, -1e30f};
#pragma unroll
            for (int i = 0; i < 4; ++i) { const int c = lane + 64 * i; float s[4];
                if (c < nv) dot4(kc + (size_t)c * 64, qs, s); else { s[0] = s[1] = s[2] = s[3] = -1e30f; }
#pragma unroll
                for (int r = 0; r < 4; ++r) { sc[r][i] = s[r]; mx[r] = fmaxf(mx[r], s[r]); } }
#pragma unroll
            for (int r = 0; r < 4; ++r) { const float M = wmax(mx[r]); float l = 0.f;
#pragma unroll
                for (int i = 0; i < 4; ++i) { const int c = lane + 64 * i; const float e = (c < nv) ? __expf(sc[r][i] - M) : 0.f; sc[r][i] = e; l += e; }
                l = wsum(l); const float il = (nv > 0) ? 1.0f / l : 0.f;
#pragma unroll
                for (int i = 0; i < 4; ++i) ps[r * 1024 + lane + 64 * i] = sc[r][i] * il; }
            __builtin_amdgcn_wave_barrier();
            oc[0] = oc[1] = oc[2] = oc[3] = 0.f;
            for (int c = 0; c < nv; ++c) { const float v = (float)vc[(size_t)c * 64 + lane];
#pragma unroll
                for (int r = 0; r < 4; ++r) oc[r] += ps[r * 1024 + c] * v; }
        }
        unsigned long long selmask;
        {
            const int s = lane; float imp = 0.f;
#pragma unroll
            for (int r = 0; r < 4; ++r) { const LAS float* p = ps + r * 1024 + 4 * s;
                imp += p[0] + p[1] + p[2] + 0.5f * p[3] + (s > 0 ? 0.5f * p[-1] : 0.f); }
            const int tb = t >> 6;
            const bool forced = (s == 0) || (s == tb) || (s == tb - 1);
            float score = forced ? 1e9f : imp; if (s > tb) score = -1e9f;
            int rank = 0;
            for (int j = 0; j < 64; ++j) { const float o = __shfl(score, j); rank += (o > score || (o == score && j < s)) ? 1 : 0; }
            selmask = __ballot(rank < TOPK && s <= tb);
        }
        __builtin_amdgcn_wave_barrier();
        {
            const h16* ks = KV + (size_t)(4 + g) * KV_CH + (size_t)b * SEQ * 64; const h16* vs = KV + (size_t)(6 + g) * KV_CH + (size_t)b * SEQ * 64;
            float mx[4] = {-1e30f, -1e30f, -1e30f, -1e30f}; int nb = 0;
            for (unsigned long long mk = selmask; mk; mk &= mk - 1, ++nb) { const int blk = __builtin_ctzll(mk); const int key = blk * 64 + lane; float s[4];
                if (key <= t) dot4(ks + (size_t)key * 64, qs, s); else { s[0] = s[1] = s[2] = s[3] = -1e30f; }
#pragma unroll
                for (int r = 0; r < 4; ++r) { ps[r * 1024 + nb * 64 + lane] = s[r]; mx[r] = fmaxf(mx[r], s[r]); } }
            float il[4];
#pragma unroll
            for (int r = 0; r < 4; ++r) { const float M = wmax(mx[r]); float l = 0.f;
                for (int i = 0; i < nb; ++i) { const float sv = ps[r * 1024 + i * 64 + lane]; const float e = (sv > -1e29f) ? __expf(sv - M) : 0.f; ps[r * 1024 + i * 64 + lane] = e; l += e; }
                il[r] = 1.0f / wsum(l); }
            __builtin_amdgcn_wave_barrier();
            os[0] = os[1] = os[2] = os[3] = 0.f; int i = 0;
            for (unsigned long long mk = selmask; mk; mk &= mk - 1, ++i) { const int blk = __builtin_ctzll(mk); const int kmax = min(64, t - blk * 64 + 1);
                for (int j = 0; j < kmax; ++j) { const float v = (float)vs[(size_t)(blk * 64 + j) * 64 + lane];
#pragma unroll
                    for (int r = 0; r < 4; ++r) os[r] += ps[r * 1024 + i * 64 + j] * v; } }
#pragma unroll
            for (int r = 0; r < 4; ++r) os[r] *= il[r];
        }
        __builtin_amdgcn_wave_barrier();
        {
            const h16* kw = KV + (size_t)(8 + g) * KV_CH + (size_t)b * SEQ * 64; const h16* vw = KV + (size_t)(10 + g) * KV_CH + (size_t)b * SEQ * 64;
            const int k0 = max(0, t - (WIN - 1)), nk = t - k0 + 1, nb = (nk + 63) >> 6;
            float mx[4] = {-1e30f, -1e30f, -1e30f, -1e30f};
            for (int i = 0; i < nb; ++i) { const int key = k0 + i * 64 + lane; float s[4];
                if (key <= t) dot4(kw + (size_t)key * 64, qs, s); else { s[0] = s[1] = s[2] = s[3] = -1e30f; }
#pragma unroll
                for (int r = 0; r < 4; ++r) { ps[r * 1024 + i * 64 + lane] = s[r]; mx[r] = fmaxf(mx[r], s[r]); } }
            float il[4];
#pragma unroll
            for (int r = 0; r < 4; ++r) { const float M = wmax(mx[r]); float l = 0.f;
                for (int i = 0; i < nb; ++i) { const float sv = ps[r * 1024 + i * 64 + lane]; const float e = (sv > -1e29f) ? __expf(sv - M) : 0.f; ps[r * 1024 + i * 64 + lane] = e; l += e; }
                il[r] = 1.0f / wsum(l); }
            __builtin_amdgcn_wave_barrier();
            ow[0] = ow[1] = ow[2] = ow[3] = 0.f;
            for (int j = 0; j < nk; ++j) { const float v = (float)vw[(size_t)(k0 + j) * 64 + lane];
#pragma unroll
                for (int r = 0; r < 4; ++r) ow[r] += ps[r * 1024 + j] * v; }
#pragma unroll
            for (int r = 0; r < 4; ++r) ow[r] *= il[r];
        }
        __builtin_amdgcn_wave_barrier();
#pragma unroll
        for (int r = 0; r < 4; ++r) { const int hd = g * 4 + r; const h16* gp = GT + (size_t)m * 32 + hd * 3;
            const float g0 = 1.0f / (1.0f + __expf(-(float)gp[0])), g1 = 1.0f / (1.0f + __expf(-(float)gp[1])), g2 = 1.0f / (1.0f + __expf(-(float)gp[2]));
            const float o = g0 * oc[r] + g1 * os[r] + g2 * ow[r];
            const float ss = wsum(o * o); const float rs = 1.0f / sqrtf(ss * (1.0f / 64.0f) + 1e-6f);
            MIX[(size_t)m * 1024 + 512 + hd * 64 + lane] = (h16)(o * rs * hng[512 + hd * 64 + lane]); }
    }
}

__device__ __forceinline__ void ln_phase(float* xio, h16* x16, const float* gam, const float* bet) {
    PHASE_IDS(); const int lane = tid_ & 63, wave = tid_ >> 6;
    const int gw = bid_ * NWAVES + wave, NGW = grd_ * NWAVES;
    f32x4 gv[4], bv[4];
#pragma unroll
    for (int j = 0; j < 4; ++j) { gv[j] = ((const f32x4*)gam)[lane + 64 * j]; bv[j] = ((const f32x4*)bet)[lane + 64 * j]; }
    for (int m = gw; m < MTOK; m += NGW) {
        f32x4* xr = (f32x4*)(xio + (size_t)m * D_MODEL) + lane;
        f32x4 v[4]; float s = 0.f;
#pragma unroll
        for (int j = 0; j < 4; ++j) { v[j] = xr[64 * j]; s += (v[j][0] + v[j][1]) + (v[j][2] + v[j][3]); }
        const float mean = wsum(s) * (1.0f / D_MODEL); float s2 = 0.f;
#pragma unroll
        for (int j = 0; j < 4; ++j) { v[j] = v[j] - mean; s2 += (v[j][0] * v[j][0] + v[j][1] * v[j][1]) + (v[j][2] * v[j][2] + v[j][3] * v[j][3]); }
        const float rstd = 1.0f / sqrtf(wsum(s2) * (1.0f / D_MODEL) + 1e-5f);
        u32x2* o16 = (u32x2*)(x16 + (size_t)m * D_MODEL) + lane;
#pragma unroll
        for (int j = 0; j < 4; ++j) { const f32x4 o = v[j] * rstd * gv[j] + bv[j]; xr[64 * j] = o; u32x2 w; w.x = pkh(o[0], o[1]); w.y = pkh(o[2], o[3]); o16[64 * j] = w; }
    }
}

__device__ __forceinline__ void ffnact_phase(const h16* U, h16* HID, const float* cw  , const float* cb  , int nrows) {
    PHASE_IDS(); const int tid = bid_ * NTHR + tid_, NT = grd_ * NTHR;
    constexpr int CPR = D_FF / 8;
    for (int i = tid; i < nrows * CPR; i += NT) {
        const int m = i / CPR, c0 = (i % CPR) * 8, t = m & (SEQ - 1);
        float v[8], gt[8];
#pragma unroll
        for (int e = 0; e < 8; ++e) { v[e] = cb[c0 + e]; gt[e] = cb[D_FF + c0 + e]; }
#pragma unroll
        for (int k = 0; k < 3; ++k) { const int dt = 2 - k; if (t >= dt) { float a[8], b[8]; const h16* r = U + (size_t)(m - dt) * D_FF2; ld8(r + c0, a); ld8(r + D_FF + c0, b);
#pragma unroll
                for (int e = 0; e < 8; ++e) { v[e] += cw[k * D_FF2 + c0 + e] * a[e]; gt[e] += cw[k * D_FF2 + D_FF + c0 + e] * b[e]; } } }
        float o[8];
#pragma unroll
        for (int e = 0; e < 8; ++e) o[e] = gt[e] / (1.0f + __expf(-gt[e])) * v[e];
        u32x4 w; w.x = pkh(o[0], o[1]); w.y = pkh(o[2], o[3]); w.z = pkh(o[4], o[5]); w.w = pkh(o[6], o[7]);
        *(u32x4*)(HID + (size_t)m * D_FF + c0) = w;
    }
}

#define GRID_SYNC() do { __threadfence(); grid.sync(); } while (0)
__global__ void __launch_bounds__(NTHR, 2) mega_fwd(MegaArgs a_unused) {
    extern __shared__ __attribute__((aligned(16))) unsigned char lds_raw[];
    LAS unsigned char* L = (LAS unsigned char*)lds_raw;
    cg::grid_group grid = cg::this_grid();
    KArgs kp0 = (KArgs)__builtin_amdgcn_kernarg_segment_ptr();
#define KP() ({ KArgs p_ = kp0; asm volatile("" : "+s"(p_)); p_; })
#define WSP() (KP()->ws)
#define OUTP() (KP()->out)
#define INP(i) (KP()->in[i])
    prep_phase(KP(), L);
    GRID_SYNC();
#pragma nounroll
    for (int l = 0; l < DEPTH; ++l) {
        {
            pg8::Gemm g{(h16*)(WSP() + WS_X16), (const h16*)(WSP() + WS_WIN) + (size_t)l * IN_PAD * D_MODEL, D_MODEL, D_MODEL, D_MODEL};
            pg8::StaticOrder S; { PHASE_IDS(); S.init(MTOK, IN_PAD, grd_, bid_); }
            pg8::EpiInProj E{(h16*)(WSP() + WS_P3), (h16*)(WSP() + WS_Q), (h16*)(WSP() + WS_KV), (h16*)(WSP() + WS_GATES)};
            pg8::gemm_phase<pg8::EpiInProj, pg8::StaticOrder, true>(L, g, S, E);
        }
        GRID_SYNC();
        elem_phase(WSP(), INP(2) + (size_t)l * 3 * CONV_W, INP(8) + (size_t)l * 1024);
        GRID_SYNC();
        {
            pg8::Gemm g{(const h16*)(WSP() + WS_KV), (const h16*)(WSP() + WS_CW1) + (size_t)l * 2 * CMP_H * CMP_K, 1024, CMP_K, CMP_K};
            pg8::CmpOrder S; { PHASE_IDS(); S.G = grd_; S.c = bid_; }
            pg8::EpiCmpH E{(h16*)(WSP() + WS_HCMP), (const float*)(WSP() + WS_CB1) + (size_t)l * 2 * CMP_H};
            pg8::gemm_phase<pg8::EpiCmpH, pg8::CmpOrder, true>(L, g, S, E);
        }
        GRID_SYNC();
        cmp2_phase(WSP(), INP(6) + (size_t)l * 2 * CMP_H * 64, INP(7) + (size_t)l * 2 * 64);
        GRID_SYNC();
        attn_v1_phase(WSP(), INP(8) + (size_t)l * 1024, L);
        GRID_SYNC();
        {
            pg8::Gemm g{(const h16*)(WSP() + WS_MIXED), (const h16*)(WSP() + WS_WOUT) + (size_t)l * D_MODEL * D_MODEL, D_MODEL, D_MODEL, D_MODEL};
            pg8::StaticOrder S; { PHASE_IDS(); S.init(MTOK, D_MODEL, grd_, bid_); }
            pg8::EpiResid E{l == 0 ? INP(0) : OUTP(), OUTP(), D_MODEL};
            pg8::gemm_phase<pg8::EpiResid, pg8::StaticOrder, true>(L, g, S, E);
        }
        GRID_SYNC();
        ln_phase(OUTP(), (h16*)(WSP() + WS_X16), INP(10) + (size_t)l * 1024, INP(11) + (size_t)l * 1024);
        GRID_SYNC();
#pragma nounroll
        for (int hf = 0; hf < 2; ++hf) {
            const size_t r0 = (size_t)hf * (MTOK / 2);
            {   pg8::Gemm g{(h16*)(WSP() + WS_X16) + r0 * D_MODEL, (const h16*)(WSP() + WS_WUP) + (size_t)l * D_FF2 * D_MODEL, D_MODEL, D_MODEL, D_MODEL};
                pg8::StaticOrder S; { PHASE_IDS(); S.init(MTOK / 2, D_FF2, grd_, bid_); }
                pg8::EpiH16 E{(h16*)(WSP() + WS_U), D_FF2};
                pg8::gemm_phase<pg8::EpiH16, pg8::StaticOrder, true>(L, g, S, E); }
            GRID_SYNC();
            ffnact_phase((const h16*)(WSP() + WS_U), (h16*)(WSP() + WS_HID), INP(13) + (size_t)l * 3 * D_FF2, INP(14) + (size_t)l * D_FF2, MTOK / 2);
            GRID_SYNC();
            {   pg8::Gemm g{(const h16*)(WSP() + WS_HID), (const h16*)(WSP() + WS_WDN) + (size_t)l * D_MODEL * D_FF, D_FF, D_FF, D_FF};
                pg8::StaticOrder S; { PHASE_IDS(); S.init(MTOK / 2, D_MODEL, grd_, bid_); }
                float* o_ = OUTP() + r0 * D_MODEL; pg8::EpiResid E{o_, o_, D_MODEL};
                pg8::gemm_phase<pg8::EpiResid, pg8::StaticOrder, true>(L, g, S, E); }
            GRID_SYNC();
        }
        ln_phase(OUTP(), (h16*)(WSP() + WS_X16), INP(16) + (size_t)l * 1024, INP(17) + (size_t)l * 1024);
        if (l + 1 < DEPTH) GRID_SYNC();
    }
}

constexpr int MEGA_LDS = 147456;
extern "C" void kernel_launch(void* const* d_in, const int* in_sizes, int n_in, void* d_out, int out_size, void* d_ws, size_t ws_size, hipStream_t stream) {
    static int grid = 0;
    if (grid == 0) {
        if (n_in != 18 || in_sizes[0] != MTOK * D_MODEL || out_size != MTOK * D_MODEL || ws_size < WS_END) { fprintf(stderr, "kernel_launch: unexpected shapes (n_in %d, ws %zu)\n", n_in, ws_size); grid = -1; return; }
        int dev = 0, cus = 0, per_cu = 0;
        (void)hipGetDevice(&dev); (void)hipDeviceGetAttribute(&cus, hipDeviceAttributeMultiprocessorCount, dev);
        (void)hipFuncSetAttribute((const void*)mega_fwd, hipFuncAttributeMaxDynamicSharedMemorySize, MEGA_LDS);
        (void)hipOccupancyMaxActiveBlocksPerMultiprocessor(&per_cu, (const void*)mega_fwd, NTHR, MEGA_LDS);
        if (per_cu < 1) { fprintf(stderr, "kernel_launch: occupancy query says %d blocks/CU\n", per_cu); per_cu = 1; }
        grid = cus;
        fprintf(stderr, "kernel_launch: grid %d (cus %d, per_cu %d)\n", grid, cus, per_cu);
    }
    if (grid < 0) return;
    MegaArgs a{}; for (int i = 0; i < 18; ++i) a.in[i] = (const float*)d_in[i]; a.out = (float*)d_out; a.ws = (unsigned char*)d_ws;
    void* args[] = {&a};
    hipError_t e = hipLaunchCooperativeKernel((const void*)mega_fwd, dim3(grid), dim3(NTHR), args, MEGA_LDS, stream);
    if (e != hipSuccess) fprintf(stderr, "cooperative launch failed: %s (grid %d)\n", hipGetErrorString(e), grid);
}
```

```cpp
#include <hip/hip_runtime.h>
#include <hip/hip_cooperative_groups.h>
namespace cg = cooperative_groups;
#include <cstdio>
#include <cstdint>

constexpr int D_MODEL = 1024, BATCH = 8, SEQ = 4096, DEPTH = 2, HD = 64;
constexpr int MTOK = BATCH * SEQ;
constexpr int CONV_W = 512, NQH = 8, NG = 2, RPG = 4;
constexpr int IN_COLS = 2840, IN_PAD = 3072;
constexpr int D_FF = 2816, D_FF2 = 5632;
constexpr int NCMP = 255, NSEL = 64, TOPK = 16, WIN = 512;
constexpr float ALPHA = 1.41421356237309515f;
constexpr int CMP_K = 2048, CMP_H = 256;

typedef _Float16 h16;
typedef h16 h16x8 __attribute__((ext_vector_type(8)));
typedef h16 h16x4 __attribute__((ext_vector_type(4)));
typedef h16 h16x2 __attribute__((ext_vector_type(2)));
typedef short s16x8 __attribute__((ext_vector_type(8)));
typedef float f32x4 __attribute__((ext_vector_type(4)));
typedef float f32x2 __attribute__((ext_vector_type(2)));
typedef unsigned u32x4 __attribute__((ext_vector_type(4)));
typedef unsigned u32x2 __attribute__((ext_vector_type(2)));
#define LAS __attribute__((address_space(3)))

#define PHASE_IDS() int tid_ = threadIdx.x, bid_ = blockIdx.x, grd_ = gridDim.x; asm volatile("" : "+v"(tid_), "+s"(bid_), "+s"(grd_))
__device__ __forceinline__ unsigned pkh(float lo, float hi) { h16x2 v = {(h16)lo, (h16)hi}; return __builtin_bit_cast(unsigned, v); }

constexpr size_t MiB = 1u << 20;
constexpr size_t WS_ROPE = 1 * MiB;
constexpr size_t WS_CB1 = 1 * MiB + 512 * 1024;
constexpr size_t WS_WIN = 2 * MiB;
constexpr size_t WS_WOUT = 14 * MiB;
constexpr size_t WS_WUP = 18 * MiB;
constexpr size_t WS_WDN = 40 * MiB;
constexpr size_t WS_CW1 = 51 * MiB;
constexpr size_t WS_KCMP = 56 * MiB;
constexpr size_t WS_HCMP = 57 * MiB;
constexpr size_t WS_X16 = 64 * MiB;
constexpr size_t WS_P3 = 128 * MiB;
constexpr size_t WS_Q = 224 * MiB;
constexpr size_t WS_KV = 256 * MiB;
constexpr size_t WS_GATES = 304 * MiB;
constexpr size_t WS_MIXED = 306 * MiB;
constexpr size_t WS_U = 128 * MiB;
constexpr size_t WS_HID = 304 * MiB;
constexpr size_t WS_END = 400 * MiB;
constexpr size_t KV_CH = (size_t)MTOK * 64;

namespace pg8 {
constexpr int BM = 256, BK = 64, HALF = 128, HTB = HALF * BK * 2, STAGE_BYTES = 8 * HTB, NXCD = 8, WGM = 8;
__host__ __device__ __forceinline__ int lds_byte(int r, int c) { const int st = (r >> 4) * 2 + (c >> 5), rr = r & 15, cc = c & 31, ob = rr * 64 + cc * 2; return st * 1024 + (ob ^ (((ob >> 9) & 1) << 5)); }
__host__ __device__ __forceinline__ void stage_rc(int b, int& R, int& C) { const int st = b / 1024, sb = b % 1024, swz = sb ^ (((sb >> 9) & 1) << 5); R = (st >> 1) * 16 + swz / 64; C = (st & 1) * 32 + (swz % 64) / 2; }
__host__ __device__ __forceinline__ int perm32(int rho) { const int n = rho >> 4, i = rho & 15; return 8 * (i >> 2) + 4 * n + (i & 3); }

struct Unit { int pm, pn; };
struct Gemm { const h16* A; const h16* Bt; int lda, ldb, K; };

struct StaticOrder {
    int nM, nN, nwg, G, c;
    __host__ __device__ void init(int M, int N, int G_, int c_) { nM = M / BM; nN = N / BM; nwg = nM * nN; G = G_; c = c_; }
    __host__ __device__ bool next(int i, Unit& u) const {
        const long L = (long)i * G + c; if (L >= nwg) return false;
        int wgid = (int)L; { const int q = nwg / NXCD, r = nwg % NXCD, xcd = wgid % NXCD, off = wgid / NXCD; wgid = (xcd < r ? xcd * (q + 1) : r * (q + 1) + (xcd - r) * q) + off; }
        const int nig = WGM * nN, gid = wgid / nig, fm = gid * WGM, gsz = (nM - fm) < WGM ? (nM - fm) : WGM;
        u.pm = fm + ((wgid % nig) % gsz); u.pn = (wgid % nig) / gsz; return true;
    }
};
struct CmpOrder {
    int G, c;
    __host__ __device__ bool next(int i, Unit& u) const { const int L = i * G + c; if (L >= 32) return false; u.pm = L; u.pn = L >> 4; return true; }
};

template <class Epi, class Sched, bool ALIGN_EPI>
__device__ __forceinline__ void gemm_phase(LAS unsigned char* lds, const Gemm g, const Sched& S, const Epi& E) {
    int tid = threadIdx.x; asm volatile("" : "+v"(tid));
    const int wid = __builtin_amdgcn_readfirstlane(tid >> 6), lane = tid & 63, wr = wid >> 2, wc = wid & 3, fr = lane & 15, fq = lane >> 4;
    const int K = g.K, nt = K / BK;
    unsigned voffA[2], voffB[2];
#pragma unroll
    for (int i = 0; i < 2; ++i) { int R, C; stage_rc(tid * 16 + i * 8192, R, C); const int Rb = Epi::PERM ? ((R & ~31) + perm32(R & 31)) : R;
        voffA[i] = (unsigned)(R * g.lda + C) * 2u; voffB[i] = (unsigned)(Rb * g.ldb + C) * 2u; }
    const size_t kstep = (size_t)(BK * 2);
    const size_t hstepA = (size_t)HALF * g.lda * 2, hstepB = (size_t)HALF * g.ldb * 2;
    const size_t tstepA = 2 * hstepA, tstepB = 2 * hstepB;
    const unsigned ldsw = (unsigned)wid * 1024u;
    const int aoff = lds_byte(wr * 64 + fr, fq * 8), boff = lds_byte(wc * 32 + fr, fq * 8);
#define PG8_SA(b, h) (((b) * 2 + (h)) * HTB)
#define PG8_SB(b, h) ((4 + (b) * 2 + (h)) * HTB)
#define PG8_STAGE(bufoff, gbase, voff) do { _Pragma("unroll") for (int _i = 0; _i < 2; ++_i) \
        __builtin_amdgcn_global_load_lds((const unsigned*)((const char*)(gbase) + (voff)[_i]), (LAS unsigned*)(lds + (bufoff) + ldsw + _i * 8192), 16, 0, 0); } while (0)
#define PG8_LDA(dst, b, h) do { _Pragma("unroll") for (int m = 0; m < 4; ++m) _Pragma("unroll") for (int k = 0; k < 2; ++k) dst[m][k] = *(const LAS h16x8*)(lds + PG8_SA(b, h) + aoff + m * 2048 + k * 1024); } while (0)
#define PG8_LDB(dst, b, h) do { _Pragma("unroll") for (int n = 0; n < 2; ++n) _Pragma("unroll") for (int k = 0; k < 2; ++k) dst[n][k] = *(const LAS h16x8*)(lds + PG8_SB(b, h) + boff + n * 2048 + k * 1024); } while (0)
#define PG8_MMA(ai, bj, At, Bt) do { __builtin_amdgcn_s_setprio(1); _Pragma("unroll") for (int m = 0; m < 4; ++m) _Pragma("unroll") for (int n = 0; n < 2; ++n) _Pragma("unroll") for (int k = 0; k < 2; ++k) \
        acc[ai][bj][m][n] = __builtin_amdgcn_mfma_f32_16x16x32_f16(Bt[n][k], At[m][k], acc[ai][bj][m][n], 0, 0, 0); __builtin_amdgcn_s_setprio(0); } while (0)
#define PG8_WAIT_V(n) asm volatile("s_waitcnt vmcnt(" #n ")" ::: "memory")
#define PG8_WAIT_L(n) asm volatile("s_waitcnt lgkmcnt(" #n ")" ::: "memory")
#define PG8_BAR __builtin_amdgcn_s_barrier()
#define PG8_SCHED __builtin_amdgcn_sched_barrier(0)
    Unit cur, nxt; int ui = 0;
    if (!S.next(0, cur)) return;
    f32x4 acc[2][2][4][2];
#pragma unroll
    for (int a = 0; a < 2; ++a)
#pragma unroll
        for (int b = 0; b < 2; ++b)
#pragma unroll
            for (int m = 0; m < 4; ++m)
#pragma unroll
                for (int n = 0; n < 2; ++n) acc[a][b][m][n] = (f32x4){0.f, 0.f, 0.f, 0.f};
    h16x8 At[4][2], B0[2][2], B1[2][2];
    const char* cA = (const char*)g.A + (size_t)cur.pm * tstepA; const char* cB = (const char*)g.Bt + (size_t)cur.pn * tstepB;
    PG8_STAGE(PG8_SB(0, 0), cB, voffB); PG8_STAGE(PG8_SB(0, 1), cB + hstepB, voffB); PG8_STAGE(PG8_SA(0, 0), cA, voffA); PG8_STAGE(PG8_SA(0, 1), cA + hstepA, voffA);
    if (wr == 1) PG8_BAR;
    PG8_WAIT_V(2); PG8_BAR;
    PG8_STAGE(PG8_SB(1, 0), cB + kstep, voffB); PG8_STAGE(PG8_SA(1, 0), cA + kstep, voffA); PG8_STAGE(PG8_SB(1, 1), cB + hstepB + kstep, voffB);
    PG8_WAIT_V(6); PG8_BAR;
    for (;;) {
        const bool has_next = S.next(ui + 1, nxt);
        const char* nA = has_next ? (const char*)g.A + (size_t)nxt.pm * tstepA : cA; const char* nB = has_next ? (const char*)g.Bt + (size_t)nxt.pn * tstepB : cB;
        for (int t = 0; t < nt; t += 2) {
            const bool last = (t == nt - 2);
            const char* a1 = cA + (size_t)(t + 1) * kstep;
            const char* a2 = last ? nA : cA + (size_t)(t + 2) * kstep; const char* b2 = last ? nB : cB + (size_t)(t + 2) * kstep;
            const char* a3 = a2 + kstep; const char* b3 = b2 + kstep;
            PG8_LDB(B0, 0, 0); PG8_LDB(B1, 0, 1); PG8_SCHED; PG8_LDA(At, 0, 0); PG8_STAGE(PG8_SA(1, 1), a1 + hstepA, voffA);
            PG8_WAIT_V(8); PG8_WAIT_L(0); PG8_BAR; PG8_MMA(0, 0, At, B0); PG8_MMA(0, 1, At, B1); PG8_BAR; PG8_SCHED;
            PG8_LDA(At, 0, 1); PG8_STAGE(PG8_SB(0, 0), b2, voffB); PG8_STAGE(PG8_SB(0, 1), b2 + hstepB, voffB); PG8_STAGE(PG8_SA(0, 0), a2, voffA);
            PG8_WAIT_V(8); PG8_WAIT_L(0); PG8_BAR; PG8_MMA(1, 0, At, B0); PG8_MMA(1, 1, At, B1); PG8_BAR; PG8_SCHED;
            PG8_LDB(B0, 1, 0); PG8_LDB(B1, 1, 1); PG8_SCHED; PG8_LDA(At, 1, 0); PG8_STAGE(PG8_SA(0, 1), a2 + hstepA, voffA);
            PG8_WAIT_V(8); PG8_WAIT_L(0); PG8_BAR; PG8_MMA(0, 0, At, B0); PG8_MMA(0, 1, At, B1); PG8_BAR; PG8_SCHED;
            PG8_LDA(At, 1, 1); PG8_STAGE(PG8_SB(1, 0), b3, voffB); PG8_STAGE(PG8_SB(1, 1), b3 + hstepB, voffB); PG8_STAGE(PG8_SA(1, 0), a3, voffA);
            PG8_WAIT_V(8); PG8_WAIT_L(0); PG8_BAR; PG8_MMA(1, 0, At, B0); PG8_MMA(1, 1, At, B1); PG8_BAR; PG8_SCHED;
        }
        if constexpr (ALIGN_EPI) { if (wr == 0) PG8_BAR; }
        E(acc, cur, wr, wc, fr, fq);
        if (!has_next) break;
#pragma unroll
        for (int a = 0; a < 2; ++a)
#pragma unroll
            for (int b = 0; b < 2; ++b)
#pragma unroll
                for (int m = 0; m < 4; ++m)
#pragma unroll
                    for (int n = 0; n < 2; ++n) acc[a][b][m][n] = (f32x4){0.f, 0.f, 0.f, 0.f};
        cur = nxt; cA = nA; cB = nB; ++ui;
        if constexpr (ALIGN_EPI) { if (wr == 1) PG8_BAR; }
    }
    PG8_WAIT_V(0);
    if constexpr (!ALIGN_EPI) { if (wr == 0) PG8_BAR; }
    PG8_BAR;
#undef PG8_SA
#undef PG8_SB
#undef PG8_STAGE
#undef PG8_LDA
#undef PG8_LDB
#undef PG8_MMA
#undef PG8_WAIT_V
#undef PG8_WAIT_L
#undef PG8_BAR
#undef PG8_SCHED
}

__device__ __forceinline__ u32x4 pack8(const f32x4 v0, const f32x4 v1) { u32x4 w; w.x = pkh(v0[0], v0[1]); w.y = pkh(v0[2], v0[3]); w.z = pkh(v1[0], v1[1]); w.w = pkh(v1[2], v1[3]); return w; }

struct EpiInProj {
    static constexpr bool PERM = true;
    h16 *P3, *Q, *KV, *GATES;
    __device__ __forceinline__ void operator()(const f32x4 (&acc)[2][2][4][2], const Unit& u, int wr, int wc, int fr, int fq) const {
        const int pn = u.pn; const int row0 = u.pm * BM + wr * 64 + fr;
#pragma unroll
        for (int ai = 0; ai < 2; ++ai)
#pragma unroll
            for (int m = 0; m < 4; ++m) { const size_t row = (size_t)(row0 + ai * HALF + m * 16);
#pragma unroll
                for (int bj = 0; bj < 2; ++bj) { const u32x4 w = pack8(acc[ai][bj][m][0], acc[ai][bj][m][1]);
                    if (pn < 6) *(u32x4*)(P3 + row * 1536 + pn * 256 + bj * 128 + wc * 32 + 8 * fq) = w;
                    else if (pn < 8) *(u32x4*)(Q + row * 512 + (pn - 6) * 256 + bj * 128 + wc * 32 + 8 * fq) = w;
                    else if (pn < 11) { const int ch = (pn - 8) * 4 + bj * 2 + (wc >> 1); *(u32x4*)(KV + (size_t)ch * KV_CH + row * 64 + (wc & 1) * 32 + 8 * fq) = w; }
                    else if (bj == 0 && wc == 0) *(u32x4*)(GATES + row * 32 + 8 * fq) = w; } }
    }
};
struct EpiH16 {
    static constexpr bool PERM = true;
    h16* O; int ldc;
    __device__ __forceinline__ void operator()(const f32x4 (&acc)[2][2][4][2], const Unit& u, int wr, int wc, int fr, int fq) const {
        const int row0 = u.pm * BM + wr * 64 + fr, col0 = u.pn * BM + wc * 32 + 8 * fq;
#pragma unroll
        for (int ai = 0; ai < 2; ++ai)
#pragma unroll
            for (int m = 0; m < 4; ++m) { h16* rowp = O + (size_t)(row0 + ai * HALF + m * 16) * ldc + col0;
#pragma unroll
                for (int bj = 0; bj < 2; ++bj) *(u32x4*)(rowp + bj * HALF) = pack8(acc[ai][bj][m][0], acc[ai][bj][m][1]); }
    }
};
struct EpiResid {
    static constexpr bool PERM = false;
    const float* res; float* out; int ldc;
    __device__ __forceinline__ void operator()(const f32x4 (&acc)[2][2][4][2], const Unit& u, int wr, int wc, int fr, int fq) const {
        const int row0 = u.pm * BM + wr * 64 + fr, col0 = u.pn * BM + wc * 32 + 4 * fq;
#pragma unroll
        for (int ai = 0; ai < 2; ++ai)
#pragma unroll
            for (int m = 0; m < 4; ++m) { const size_t off = (size_t)(row0 + ai * HALF + m * 16) * ldc + col0;
#pragma unroll
                for (int bj = 0; bj < 2; ++bj)
#pragma unroll
                    for (int n = 0; n < 2; ++n) { const f32x4 r = *(const f32x4*)(res + off + bj * HALF + n * 16); *(f32x4*)(out + off + bj * HALF + n * 16) = r * ALPHA + acc[ai][bj][m][n]; } }
    }
};
__device__ __forceinline__ float gelu_tanh(float x) {
    const float u = 0.7978845608028654f * (x + 0.044715f * x * x * x);
    const float e = __expf(2.0f * u);
    const float th = 1.0f - 2.0f / (e + 1.0f);
    return 0.5f * x * (1.0f + th);
}
struct EpiCmpH {
    static constexpr bool PERM = true;
    h16* H; const float* cb1;
    __device__ __forceinline__ void operator()(const f32x4 (&acc)[2][2][4][2], const Unit& u, int wr, int wc, int fr, int fq) const {
        const int row0 = u.pm * BM + wr * 64 + fr, col0 = wc * 32 + 8 * fq;
        f32x4 bv[2][2];
#pragma unroll
        for (int bj = 0; bj < 2; ++bj)
#pragma unroll
            for (int n = 0; n < 2; ++n) bv[bj][n] = *(const f32x4*)(cb1 + u.pn * 256 + col0 + bj * HALF + 4 * n);
#pragma unroll
        for (int ai = 0; ai < 2; ++ai)
#pragma unroll
            for (int m = 0; m < 4; ++m) { h16* rowp = H + (size_t)(row0 + ai * HALF + m * 16) * 256 + col0;
#pragma unroll
                for (int bj = 0; bj < 2; ++bj) { f32x4 v0 = acc[ai][bj][m][0] + bv[bj][0], v1 = acc[ai][bj][m][1] + bv[bj][1];
#pragma unroll
                    for (int e = 0; e < 4; ++e) { v0[e] = gelu_tanh(v0[e]); v1[e] = gelu_tanh(v1[e]); }
                    *(u32x4*)(rowp + bj * HALF) = pack8(v0, v1); } }
    }
};
}

constexpr int NTHR = 512, NWAVES = 8;
constexpr int GEMM_LDS = 131072 + 16384;

__device__ __forceinline__ void transpose_item(const float* W, int K, int N, h16* WT, LAS float* scr, int item, int nblk, int lane) {
    const int kb = item / nblk, nb = item % nblk, k0 = 64 * kb, n0 = 32 * nb;
#pragma unroll 8
    for (int i = 0; i < 32; ++i) { const int kk = 2 * i + (lane >> 5); const int n = n0 + (lane & 31); scr[kk * 33 + (lane & 31)] = (n < N) ? W[(size_t)(k0 + kk) * N + n] : 0.f; }
    asm volatile("s_waitcnt lgkmcnt(0)" ::: "memory");
    const int c = lane & 7;
#pragma unroll
    for (int j = 0; j < 4; ++j) { const int n = (lane >> 3) + 8 * j; const LAS float* s = scr + (8 * c) * 33 + n;
        u32x4 o; o.x = pkh(s[0 * 33], s[1 * 33]); o.y = pkh(s[2 * 33], s[3 * 33]); o.z = pkh(s[4 * 33], s[5 * 33]); o.w = pkh(s[6 * 33], s[7 * 33]);
        *(u32x4*)(WT + (size_t)(n0 + n) * K + k0 + 8 * c) = o; }
    asm volatile("s_waitcnt lgkmcnt(0)" ::: "memory");
}
struct MegaArgs { const float* in[18]; float* out; unsigned char* ws; };
typedef const __attribute__((address_space(4))) MegaArgs* KArgs;
__device__ __forceinline__ void prep_phase(KArgs ap, LAS unsigned char* lds) {
#define a (*ap)
    PHASE_IDS(); const int tid = tid_, lane = tid & 63, wave = tid >> 6;
    LAS float* scr = (LAS float*)lds + wave * 64 * 33;
    const int gw = bid_ * NWAVES + wave, NGW = grd_ * NWAVES;
    unsigned char* ws = a.ws;
    constexpr int I_IN = 16 * 96, I_OUT = 16 * 32, I_UP = 16 * 176, I_DN = 44 * 32, I_C1 = 32 * 8;
    constexpr int PER_L = I_IN + I_OUT + I_UP + I_DN + 2 * I_C1;
    for (int it = gw; it < DEPTH * PER_L; it += NGW) {
        const int l = it / PER_L; int r = it % PER_L;
        if (r < I_IN) { transpose_item(a.in[1] + (size_t)l * D_MODEL * IN_COLS, D_MODEL, IN_COLS, (h16*)(ws + WS_WIN) + (size_t)l * IN_PAD * D_MODEL, scr, r, 96, lane); continue; } r -= I_IN;
        if (r < I_OUT) { transpose_item(a.in[9] + (size_t)l * D_MODEL * D_MODEL, D_MODEL, D_MODEL, (h16*)(ws + WS_WOUT) + (size_t)l * D_MODEL * D_MODEL, scr, r, 32, lane); continue; } r -= I_OUT;
        if (r < I_UP) { transpose_item(a.in[12] + (size_t)l * D_MODEL * D_FF2, D_MODEL, D_FF2, (h16*)(ws + WS_WUP) + (size_t)l * D_FF2 * D_MODEL, scr, r, 176, lane); continue; } r -= I_UP;
        if (r < I_DN) { transpose_item(a.in[15] + (size_t)l * D_FF * D_MODEL, D_FF, D_MODEL, (h16*)(ws + WS_WDN) + (size_t)l * D_MODEL * D_FF, scr, r, 32, lane); continue; } r -= I_DN;
        const int kv = r / I_C1; r %= I_C1;
        transpose_item(a.in[4] + (size_t)(l * 2 + kv) * CMP_K * CMP_H, CMP_K, CMP_H, (h16*)(ws + WS_CW1) + (size_t)(l * 2 + kv) * CMP_H * CMP_K, scr, r, 8, lane);
    }
    const float* x = a.in[0]; h16* x16 = (h16*)(ws + WS_X16);
    for (int m = gw; m < MTOK; m += NGW) {
        const f32x4* xr = (const f32x4*)(x + (size_t)m * D_MODEL) + lane; u32x2* o = (u32x2*)(x16 + (size_t)m * D_MODEL) + lane;
#pragma unroll
        for (int j = 0; j < 4; ++j) { const f32x4 v = xr[64 * j]; u32x2 w; w.x = pkh(v[0], v[1]); w.y = pkh(v[2], v[3]); o[64 * j] = w; }
    }
    {
        float* rope = (float*)(ws + WS_ROPE);
        const int gt = bid_ * NTHR + tid, NT = grd_ * NTHR;
        for (int i = gt; i < SEQ * 8; i += NT) { const int t = i >> 3, j = i & 7;
            const float inv = (float)pow(500000.0, -(double)j / 8.0);
            const float ang = (float)t * inv;
            rope[t * 16 + j] = (float)cos((double)ang); rope[t * 16 + 8 + j] = (float)sin((double)ang); }
        float* cb1 = (float*)(ws + WS_CB1);
        for (int i = gt; i < DEPTH * 2 * CMP_H; i += NT) { const int lk = i / CMP_H, n = i % CMP_H;
            const float* pe = a.in[3] + (size_t)lk * CMP_K; const float* w1 = a.in[4] + (size_t)lk * CMP_K * CMP_H;
            float s = a.in[5][i];
            for (int k = 0; k < CMP_K; ++k) s += pe[k] * w1[(size_t)k * CMP_H + n];
            cb1[i] = s; }
    }
#undef a
}

__device__ __forceinline__ void ld8(const h16* p, float (&v)[8]) { const h16x8 h = *(const h16x8*)p;
#pragma unroll
    for (int i = 0; i < 8; ++i) v[i] = (float)h[i]; }
__device__ __forceinline__ void elem_phase(unsigned char* ws, const float* convw  , const float* hng  ) {
    PHASE_IDS(); const int lane = tid_ & 63, wave = tid_ >> 6;
    const int gw = bid_ * NWAVES + wave, NGW = grd_ * NWAVES;
    const h16* P3 = (const h16*)(ws + WS_P3); h16* MIX = (h16*)(ws + WS_MIXED);
    h16* Q = (h16*)(ws + WS_Q); h16* KV = (h16*)(ws + WS_KV); const float* rope = (const float*)(ws + WS_ROPE);
    const int c0 = lane * 8;
    float w0[8], w1[8], w2[8], gg[8];
#pragma unroll
    for (int i = 0; i < 8; ++i) { w0[i] = convw[c0 + i]; w1[i] = convw[512 + c0 + i]; w2[i] = convw[1024 + c0 + i]; gg[i] = hng[c0 + i]; }
    for (int m = gw; m < MTOK; m += NGW) {
        const int t = m & (SEQ - 1);
        const h16* r0 = P3 + (size_t)m * 1536;
        float bg[8], z0[8], z1[8], z2[8], a_[8], b_[8];
        ld8(r0 + c0, bg);
        ld8(r0 + 512 + c0, a_); ld8(r0 + 1024 + c0, b_);
#pragma unroll
        for (int i = 0; i < 8; ++i) z2[i] = a_[i] * b_[i];
        if (t >= 1) { ld8(r0 - 1536 + 512 + c0, a_); ld8(r0 - 1536 + 1024 + c0, b_);
#pragma unroll
            for (int i = 0; i < 8; ++i) z1[i] = a_[i] * b_[i]; } else {
#pragma unroll
            for (int i = 0; i < 8; ++i) z1[i] = 0.f; }
        if (t >= 2) { ld8(r0 - 3072 + 512 + c0, a_); ld8(r0 - 3072 + 1024 + c0, b_);
#pragma unroll
            for (int i = 0; i < 8; ++i) z0[i] = a_[i] * b_[i]; } else {
#pragma unroll
            for (int i = 0; i < 8; ++i) z0[i] = 0.f; }
        float y[8]; float ss = 0.f;
#pragma unroll
        for (int i = 0; i < 8; ++i) { y[i] = bg[i] * (w0[i] * z0[i] + w1[i] * z1[i] + w2[i] * z2[i]); ss += y[i] * y[i]; }
        ss += __shfl_xor(ss, 1); ss += __shfl_xor(ss, 2); ss += __shfl_xor(ss, 4);
        const float rs = 1.0f / sqrtf(ss * (1.0f / 64.0f) + 1e-6f);
        u32x4 o; o.x = pkh(y[0] * rs * gg[0], y[1] * rs * gg[1]); o.y = pkh(y[2] * rs * gg[2], y[3] * rs * gg[3]); o.z = pkh(y[4] * rs * gg[4], y[5] * rs * gg[5]); o.w = pkh(y[6] * rs * gg[6], y[7] * rs * gg[7]);
        *(u32x4*)(MIX + (size_t)m * 1024 + c0) = o;
        if (lane < 14) {
            h16* p;
            if (lane < 8) p = Q + (size_t)m * 512 + lane * 64;
            else { const int k = lane - 8; const int ch = (k >> 1) * 4 + (k & 1); p = KV + (size_t)ch * KV_CH + (size_t)m * 64; }
            float x1[8], x2[8]; ld8(p, x1); ld8(p + 8, x2);
            const float* cs = rope + t * 16;
            float o1[8], o2[8];
#pragma unroll
            for (int j = 0; j < 8; ++j) { const float c = cs[j], s = cs[8 + j]; o1[j] = x1[j] * c - x2[j] * s; o2[j] = x2[j] * c + x1[j] * s; }
            u32x4 a; a.x = pkh(o1[0], o1[1]); a.y = pkh(o1[2], o1[3]); a.z = pkh(o1[4], o1[5]); a.w = pkh(o1[6], o1[7]);
            u32x4 b; b.x = pkh(o2[0], o2[1]); b.y = pkh(o2[2], o2[3]); b.z = pkh(o2[4], o2[5]); b.w = pkh(o2[6], o2[7]);
            *(u32x4*)p = a; *(u32x4*)(p + 8) = b;
        }
    }
}

__device__ __forceinline__ void cmp2_phase(unsigned char* ws, const float* w2  , const float* b2  ) {
    PHASE_IDS(); const int lane = tid_ & 63, wave = tid_ >> 6;
    const int gw = bid_ * NWAVES + wave, NGW = grd_ * NWAVES;
    const h16* H = (const h16*)(ws + WS_HCMP); h16* KC = (h16*)(ws + WS_KCMP);
    for (int r = gw; r < 8192; r += NGW) {
        const int ch = r >> 11, b = (r >> 8) & 7, c = r & 255, kv = ch >> 1, g = ch & 1;
        float s = b2[kv * 64 + lane];
        const h16* hr = H + (size_t)r * 256; const float* w = w2 + (size_t)kv * 256 * 64 + lane;
        for (int j = 0; j < 256; ++j) s += (float)hr[j] * w[j * 64];
        if (c == 255) s = 0.f;
        KC[((size_t)((kv * BATCH + b) * NG + g) * 256 + c) * 64 + lane] = (h16)s;
    }
}

namespace att {
typedef float f32x16 __attribute__((ext_vector_type(16)));
typedef short v4i16 __attribute__((ext_vector_type(4)));
constexpr float C2 = 0.125f * 1.4426950408889634f;
constexpr float NEGB = -1e30f, MINIT = -1e20f, THR = 8.0f;
constexpr int L_K = 0, L_V = 16384, L_WS = 32768, L_SG = 34816, L_SEL = 37888, L_IMP = 38912, OST_PITCH = 68, L_END = L_IMP + 8 * 32 * OST_PITCH * 4;
static_assert(L_END <= 131072, "attention LDS");

__device__ __forceinline__ int crow(int r, int hi) { return (r & 3) + 8 * (r >> 2) + 4 * hi; }
__device__ __forceinline__ void glds16(const void* gsrc, unsigned lds_dst) { unsigned keep;
    asm volatile("s_mov_b32 %0, m0\n\ts_mov_b32 m0, %2\n\ts_nop 0\n\tglobal_load_lds_dwordx4 %1, off\n\ts_mov_b32 m0, %0" : "=&s"(keep) : "v"(gsrc), "s"(lds_dst) : "memory"); }
#define ATT_WAIT_BAR(N) asm volatile("s_waitcnt vmcnt(" #N ") lgkmcnt(0)\n\ts_barrier" ::: "memory")
__device__ __forceinline__ float hmax2(float m) { auto rr = __builtin_amdgcn_permlane32_swap(__float_as_uint(m), __float_as_uint(m), false, false); return fmaxf(__uint_as_float(rr[0]), __uint_as_float(rr[1])); }
__device__ __forceinline__ float hsum2(float m) { auto rr = __builtin_amdgcn_permlane32_swap(__float_as_uint(m), __float_as_uint(m), false, false); return __uint_as_float(rr[0]) + __uint_as_float(rr[1]); }
__device__ __forceinline__ float rowmax(const f32x16& p0, const f32x16& p1) {
    float a = fmaxf(p0[0], p1[0]);
#pragma unroll
    for (int r = 1; r < 16; ++r) a = fmaxf(a, fmaxf(p0[r], p1[r]));
    return hmax2(a);
}
__device__ __forceinline__ void qkt(f32x16& p0, f32x16& p1, const LAS char* kslot, const h16x8 (&qr)[4], float cinit, int r32, int hi) {
    f32x16 c;
#pragma unroll
    for (int r = 0; r < 16; ++r) c[r] = cinit;
    const LAS char* kb = kslot + hi * 1024 + r32 * 16;
#pragma unroll
    for (int d0 = 0; d0 < 4; ++d0) {
        const h16x8 b0 = *(const LAS h16x8*)(kb + d0 * 2048), b1 = *(const LAS h16x8*)(kb + d0 * 2048 + 512);
        if (d0 == 0) { p0 = __builtin_amdgcn_mfma_f32_32x32x16_f16(b0, qr[0], c, 0, 0, 0); p1 = __builtin_amdgcn_mfma_f32_32x32x16_f16(b1, qr[0], c, 0, 0, 0); }
        else { p0 = __builtin_amdgcn_mfma_f32_32x32x16_f16(b0, qr[d0], p0, 0, 0, 0); p1 = __builtin_amdgcn_mfma_f32_32x32x16_f16(b1, qr[d0], p1, 0, 0, 0); }
    }
}
__device__ __forceinline__ void mask_range(f32x16& p0, f32x16& p1, int lo, int hb, int hi) {
#pragma unroll
    for (int r = 0; r < 16; ++r) { const int k = crow(r, hi); if (k < lo || k > hb) p0[r] = NEGB; if (k + 32 < lo || k + 32 > hb) p1[r] = NEGB; }
}
__device__ __forceinline__ h16x8 vfrag(const LAS char* p) {
    const v4i16 lo = __builtin_amdgcn_ds_read_tr16_b64_v4i16((LAS v4i16*)p), hi = __builtin_amdgcn_ds_read_tr16_b64_v4i16((LAS v4i16*)(p + 512));
    typedef short s16x8_t __attribute__((ext_vector_type(8)));
    const s16x8_t v = {lo[0], lo[1], lo[2], lo[3], hi[0], hi[1], hi[2], hi[3]};
    return __builtin_bit_cast(h16x8, v);
}
__device__ __forceinline__ void pv(f32x16 (&o)[2], const LAS char* vp, const f32x16& p0, const f32x16& p1) {
    u32x4 w[4];
#pragma unroll
    for (int i = 0; i < 4; ++i) { w[0][i] = pkh(p0[2 * i], p0[2 * i + 1]); w[1][i] = pkh(p0[8 + 2 * i], p0[9 + 2 * i]); w[2][i] = pkh(p1[2 * i], p1[2 * i + 1]); w[3][i] = pkh(p1[8 + 2 * i], p1[9 + 2 * i]); }
#pragma unroll
    for (int d0 = 0; d0 < 2; ++d0)
#pragma unroll
        for (int ks = 0; ks < 4; ++ks) o[d0] = __builtin_amdgcn_mfma_f32_32x32x16_f16(__builtin_bit_cast(h16x8, w[ks]), vfrag(vp + d0 * 4096 + ks * 1024), o[d0], 0, 0, 0);
}
template <bool HAS_O>
__device__ __forceinline__ void sm_step(f32x16& p0, f32x16& p1, float& mref, float& l, f32x16 (&o)[2], LAS float* wsf, int r32, int hi) {
    const float rm = rowmax(p0, p1);
    if (__any(rm > mref + THR)) {
        const float mn = fmaxf(mref, rm), al = __builtin_amdgcn_exp2f(mref - mn);
        l *= al; mref = mn;
        if (HAS_O) {
            if (hi == 0) wsf[r32] = al;
            asm volatile("s_waitcnt lgkmcnt(0)" ::: "memory");
#pragma unroll
            for (int r = 0; r < 16; ++r) { const float a = wsf[crow(r, hi)]; o[0][r] *= a; o[1][r] *= a; }
        }
    }
    float s = 0.f;
#pragma unroll
    for (int r = 0; r < 16; ++r) { p0[r] = __builtin_amdgcn_exp2f(p0[r] - mref); p1[r] = __builtin_amdgcn_exp2f(p1[r] - mref); s += p0[r] + p1[r]; }
    l += s;
}

struct Ptrs { const h16* Q; const h16* KV; const h16* KCMP; const h16* GT; h16* MIX; const float* hng; };

__device__ __forceinline__ void attn_unit(const Ptrs& P, int b, int g, int qt, LAS char* shm) {
    PHASE_IDS();
    const int tid = tid_, lane = tid & 63, r32 = lane & 31, hi = lane >> 5, wid = __builtin_amdgcn_readfirstlane(tid >> 6);
    const int hr = wid >> 1, qh = wid & 1, hd = g * 4 + hr;
    const int m0 = b * SEQ + 64 * qt, ql = 32 * qh + r32, tq = 64 * qt + ql;
    const unsigned lds0 = (unsigned)(uintptr_t)shm;
    LAS float* wsf = (LAS float*)(shm + L_WS) + wid * 64;
    LAS float* SG = (LAS float*)(shm + L_SG);
    LAS unsigned long long* SELM = (LAS unsigned long long*)(shm + L_SEL);
    LAS float* IMPH = (LAS float*)(shm + L_IMP);
    const bool need_topk = qt >= 16;
    if (tid < 256) { const int q = tid & 63, rr = tid >> 6; const h16* gp = P.GT + (size_t)(m0 + q) * 32 + (g * 4 + rr) * 3;
#pragma unroll
        for (int j = 0; j < 3; ++j) SG[j * 256 + rr * 64 + q] = 1.0f / (1.0f + __expf(-(float)gp[j])); }
    if (need_topk) { LAS f32x4* z = (LAS f32x4*)IMPH;
#pragma unroll
        for (int i = 0; i < 8; ++i) z[tid + i * NTHR] = (f32x4){0.f, 0.f, 0.f, 0.f}; }
    h16x8 qr[4];
    { const h16* qp = P.Q + (size_t)(m0 + ql) * 512 + hd * 64 + hi * 8;
#pragma unroll
      for (int d0 = 0; d0 < 4; ++d0) { const h16x8 v = *(const h16x8*)(qp + d0 * 16); h16x8 s;
#pragma unroll
          for (int i = 0; i < 8; ++i) s[i] = (h16)((float)v[i] * C2);
          qr[d0] = s; } }
    const unsigned kdst = lds0 + L_K + wid * 1024, vdst = lds0 + L_V + wid * 1024;
    const size_t koff = (size_t)lane * 64 + wid * 8, voff = (size_t)(16 * (wid & 3) + (lane >> 2)) * 64 + (wid >> 2) * 32 + (lane & 3) * 8;
#define ATT_DMA(Kb, Vb, kt, slot) do { glds16((Kb) + (size_t)(kt) * 4096 + koff, (unsigned)__builtin_amdgcn_readfirstlane(kdst + (slot) * 8192)); \
                                       glds16((Vb) + (size_t)(kt) * 4096 + voff, (unsigned)__builtin_amdgcn_readfirstlane(vdst + (slot) * 8192)); } while (0)
    const LAS char* kbase = (const LAS char*)shm + L_K;
    const LAS char* vbase = (const LAS char*)shm + L_V + ((lane >> 4) & 1) * 32 + (lane & 3) * 8 + (4 * hi + ((lane & 15) >> 2)) * 64;
    f32x16 comb[2], o[2], p0, p1;
#pragma unroll
    for (int r = 0; r < 16; ++r) { comb[0][r] = 0.f; comb[1][r] = 0.f; }
    asm volatile("s_waitcnt vmcnt(0)" ::: "memory");
#define ATT_COMBINE(fval) do { if (hi == 0) wsf[32 + r32] = (fval); asm volatile("s_waitcnt lgkmcnt(0)" ::: "memory"); \
        _Pragma("unroll") for (int r = 0; r < 16; ++r) { const float f_ = wsf[32 + crow(r, hi)]; comb[0][r] += o[0][r] * f_; comb[1][r] += o[1][r] * f_; } } while (0)

    {
        const h16* Kb = P.KCMP + (size_t)((0 * BATCH + b) * NG + g) * 256 * 64; const h16* Vb = P.KCMP + (size_t)((1 * BATCH + b) * NG + g) * 256 * 64;
        const int nct = (qt >> 4) + 1;
        const int cmax = (tq >= 31) ? ((tq - 31) >> 4) : -1;
        float mref = MINIT, l = 0.f;
        ATT_DMA(Kb, Vb, 0, 0);
        for (int ct = 0; ct < nct; ++ct) {
            const int slot = ct & 1;
            if (ct + 1 < nct) { ATT_DMA(Kb, Vb, ct + 1, slot ^ 1); ATT_WAIT_BAR(2); } else { ATT_WAIT_BAR(0); }
            qkt(p0, p1, kbase + slot * 8192, qr, 0.f, r32, hi);
            mask_range(p0, p1, 0, cmax - 64 * ct, hi);
            sm_step<false>(p0, p1, mref, l, o, wsf, r32, hi);
            ATT_WAIT_BAR(0);
        }
        l = hsum2(l);
        const float il = (l > 0.f) ? 1.0f / l : 0.f;
#pragma unroll
        for (int r = 0; r < 16; ++r) { o[0][r] = 0.f; o[1][r] = 0.f; }
        ATT_DMA(Kb, Vb, 0, 0);
        for (int ct = 0; ct < nct; ++ct) {
            const int slot = ct & 1;
            if (ct + 1 < nct) { ATT_DMA(Kb, Vb, ct + 1, slot ^ 1); ATT_WAIT_BAR(2); } else { ATT_WAIT_BAR(0); }
            qkt(p0, p1, kbase + slot * 8192, qr, 0.f, r32, hi);
            mask_range(p0, p1, 0, cmax - 64 * ct, hi);
#pragma unroll
            for (int r = 0; r < 16; ++r) { p0[r] = __builtin_amdgcn_exp2f(p0[r] - mref) * il; p1[r] = __builtin_amdgcn_exp2f(p1[r] - mref) * il; }
            if (need_topk) {
                LAS float* iw = IMPH + (hr * 64 + ql) * 64 + 16 * ct + hi;
#pragma unroll
                for (int j = 0; j < 4; ++j) {
                    const float e0 = 0.5f * p0[4 * j + 3], a0 = p0[4 * j] + p0[4 * j + 1] + p0[4 * j + 2] + e0;
                    const float e1 = 0.5f * p1[4 * j + 3], a1 = p1[4 * j] + p1[4 * j + 1] + p1[4 * j + 2] + e1;
                    __hip_atomic_fetch_add(iw + 2 * j, a0, __ATOMIC_RELAXED, __HIP_MEMORY_SCOPE_WORKGROUP);
                    __hip_atomic_fetch_add(iw + 2 * j + 1, e0, __ATOMIC_RELAXED, __HIP_MEMORY_SCOPE_WORKGROUP);
                    __hip_atomic_fetch_add(iw + 8 + 2 * j, a1, __ATOMIC_RELAXED, __HIP_MEMORY_SCOPE_WORKGROUP);
                    if (16 * ct + 8 + 2 * j + hi + 1 < 64) __hip_atomic_fetch_add(iw + 8 + 2 * j + 1, e1, __ATOMIC_RELAXED, __HIP_MEMORY_SCOPE_WORKGROUP);
                }
            }
            pv(o, vbase + slot * 8192, p0, p1);
            ATT_WAIT_BAR(0);
        }
        ATT_COMBINE(SG[0 * 256 + hr * 64 + ql]);
    }
    if (need_topk) {
        const int s = lane; const bool cand = (s >= 1) && (s <= qt - 2); const bool forced = (s == 0) || (s == qt) || (s == qt - 1);
        for (int i = 0; i < 8; ++i) {
            const int q = wid * 8 + i;
            const float v = ((IMPH[(0 * 64 + q) * 64 + s] + IMPH[(1 * 64 + q) * 64 + s]) + IMPH[(2 * 64 + q) * 64 + s]) + IMPH[(3 * 64 + q) * 64 + s];
            const unsigned khi = cand ? __float_as_uint(v) : 0u, klo = cand ? (unsigned)(63 - s) : 0u;
            const unsigned long long my = ((unsigned long long)khi << 32) | klo;
            int rank = 0;
#pragma unroll
            for (int j = 0; j < 64; ++j) { const unsigned long long kj = ((unsigned long long)__builtin_amdgcn_readlane(khi, j) << 32) | (unsigned)__builtin_amdgcn_readlane(klo, j); rank += (kj > my) ? 1 : 0; }
            const unsigned long long mk = __ballot(forced || (cand && rank < TOPK - 3));
            if (lane == 0) SELM[q] = mk;
        }
    } else if (tid < 64) SELM[tid] = (2ull << qt) - 1ull;
    asm volatile("s_waitcnt lgkmcnt(0)\n\ts_barrier" ::: "memory");
    {
        const h16* Kb = P.KV + (size_t)(4 + g) * KV_CH + (size_t)b * SEQ * 64; const h16* Vb = P.KV + (size_t)(6 + g) * KV_CH + (size_t)b * SEQ * 64;
        const unsigned long long sel = SELM[ql];
        float mref = MINIT, l = 0.f;
#pragma unroll
        for (int r = 0; r < 16; ++r) { o[0][r] = 0.f; o[1][r] = 0.f; }
        ATT_DMA(Kb, Vb, 0, 0);
        for (int kb = 0; kb <= qt; ++kb) {
            const int slot = kb & 1;
            if (kb < qt) { ATT_DMA(Kb, Vb, kb + 1, slot ^ 1); ATT_WAIT_BAR(2); } else { ATT_WAIT_BAR(0); }
            qkt(p0, p1, kbase + slot * 8192, qr, ((sel >> kb) & 1ull) ? 0.f : NEGB, r32, hi);
            if (kb == qt) mask_range(p0, p1, 0, ql, hi);
            sm_step<true>(p0, p1, mref, l, o, wsf, r32, hi);
            pv(o, vbase + slot * 8192, p0, p1);
            ATT_WAIT_BAR(0);
        }
        l = hsum2(l);
        ATT_COMBINE(SG[1 * 256 + hr * 64 + ql] * ((l > 0.f) ? 1.0f / l : 0.f));
    }
    {
        const h16* Kb = P.KV + (size_t)(8 + g) * KV_CH + (size_t)b * SEQ * 64; const h16* Vb = P.KV + (size_t)(10 + g) * KV_CH + (size_t)b * SEQ * 64;
        const int k0 = (qt >= 8) ? qt - 8 : 0;
        float mref = MINIT, l = 0.f;
#pragma unroll
        for (int r = 0; r < 16; ++r) { o[0][r] = 0.f; o[1][r] = 0.f; }
        ATT_DMA(Kb, Vb, k0, 0);
        for (int kb = k0; kb <= qt; ++kb) {
            const int slot = (kb - k0) & 1;
            if (kb < qt) { ATT_DMA(Kb, Vb, kb + 1, slot ^ 1); ATT_WAIT_BAR(2); } else { ATT_WAIT_BAR(0); }
            qkt(p0, p1, kbase + slot * 8192, qr, 0.f, r32, hi);
            if (kb == qt) mask_range(p0, p1, 0, ql, hi);
            else if (kb == qt - 8) mask_range(p0, p1, ql + 1, 63, hi);
            sm_step<true>(p0, p1, mref, l, o, wsf, r32, hi);
            pv(o, vbase + slot * 8192, p0, p1);
            ATT_WAIT_BAR(0);
        }
        l = hsum2(l);
        ATT_COMBINE(SG[2 * 256 + hr * 64 + ql] * ((l > 0.f) ? 1.0f / l : 0.f));
    }
    {
        LAS float* ost = (LAS float*)(shm + L_IMP) + wid * 32 * OST_PITCH;
#pragma unroll
        for (int r = 0; r < 16; ++r) { ost[crow(r, hi) * OST_PITCH + r32] = comb[0][r]; ost[crow(r, hi) * OST_PITCH + 32 + r32] = comb[1][r]; }
        asm volatile("s_waitcnt lgkmcnt(0)" ::: "memory");
        const int row = lane >> 1, half = lane & 1;
        f32x4 v[8]; float ss = 0.f;
#pragma unroll
        for (int i = 0; i < 8; ++i) { v[i] = *(const LAS f32x4*)(ost + row * OST_PITCH + half * 32 + 4 * i); ss += (v[i][0] * v[i][0] + v[i][1] * v[i][1]) + (v[i][2] * v[i][2] + v[i][3] * v[i][3]); }
        ss += __shfl_xor(ss, 1);
        const float rs = 1.0f / sqrtf(ss * (1.0f / 64.0f) + 1e-6f);
        const float* gp = P.hng + 512 + hd * 64 + half * 32;
        h16* op = P.MIX + (size_t)(m0 + 32 * qh + row) * 1024 + 512 + hd * 64 + half * 32;
#pragma unroll
        for (int i = 0; i < 4; ++i) { const f32x4 g0 = *(const f32x4*)(gp + 8 * i), g1 = *(const f32x4*)(gp + 8 * i + 4); const f32x4 a = v[2 * i] * rs * g0, c = v[2 * i + 1] * rs * g1;
            u32x4 w; w.x = pkh(a[0], a[1]); w.y = pkh(a[2], a[3]); w.z = pkh(c[0], c[1]); w.w = pkh(c[2], c[3]); *(u32x4*)(op + 8 * i) = w; }
    }
    asm volatile("s_waitcnt vmcnt(0) lgkmcnt(0)\n\ts_barrier" ::: "memory");
#undef ATT_DMA
#undef ATT_COMBINE
}

__device__ __forceinline__ void attn_phase(const Ptrs& P, LAS char* shm) {
    PHASE_IDS();
    const int G = grd_, bx = bid_;
    if (G == 256) {
        const int v = (bx & 7) * 32 + (bx >> 3);
        const int pair = v >> 4, s = v & 15;
        for (int i = 0; i < 4; ++i) { const int qt = (i == 0) ? 63 - s : (i == 1) ? 32 + s : (i == 2) ? 31 - s : s; attn_unit(P, pair >> 1, pair & 1, qt, shm); }
    } else {
        for (int u = bx; u < BATCH * NG * 64; u += G) attn_unit(P, u >> 7, (u >> 6) & 1, 63 - (u & 63), shm);
    }
}
}

__device__ __forceinline__ float wsum(float v) {
#pragma unroll
    for (int o = 1; o < 64; o <<= 1) v += __shfl_xor(v, o); return v; }
__device__ __forceinline__ void ln_phase(float* xio, h16* x16, const float* gam, const float* bet) {
    PHASE_IDS(); const int lane = tid_ & 63, wave = tid_ >> 6;
    const int gw = bid_ * NWAVES + wave, NGW = grd_ * NWAVES;
    f32x4 gv[4], bv[4];
#pragma unroll
    for (int j = 0; j < 4; ++j) { gv[j] = ((const f32x4*)gam)[lane + 64 * j]; bv[j] = ((const f32x4*)bet)[lane + 64 * j]; }
    for (int m = gw; m < MTOK; m += NGW) {
        f32x4* xr = (f32x4*)(xio + (size_t)m * D_MODEL) + lane;
        f32x4 v[4]; float s = 0.f;
#pragma unroll
        for (int j = 0; j < 4; ++j) { v[j] = xr[64 * j]; s += (v[j][0] + v[j][1]) + (v[j][2] + v[j][3]); }
        const float mean = wsum(s) * (1.0f / D_MODEL); float s2 = 0.f;
#pragma unroll
        for (int j = 0; j < 4; ++j) { v[j] = v[j] - mean; s2 += (v[j][0] * v[j][0] + v[j][1] * v[j][1]) + (v[j][2] * v[j][2] + v[j][3] * v[j][3]); }
        const float rstd = 1.0f / sqrtf(wsum(s2) * (1.0f / D_MODEL) + 1e-5f);
        u32x2* o16 = (u32x2*)(x16 + (size_t)m * D_MODEL) + lane;
#pragma unroll
        for (int j = 0; j < 4; ++j) { const f32x4 o = v[j] * rstd * gv[j] + bv[j]; xr[64 * j] = o; u32x2 w; w.x = pkh(o[0], o[1]); w.y = pkh(o[2], o[3]); o16[64 * j] = w; }
    }
}

__device__ __forceinline__ void ffnact_phase(const h16* U, h16* HID, const float* cw  , const float* cb  , int nrows) {
    PHASE_IDS(); const int tid = bid_ * NTHR + tid_, NT = grd_ * NTHR;
    constexpr int CPR = D_FF / 8;
    for (int i = tid; i < nrows * CPR; i += NT) {
        const int m = i / CPR, c0 = (i % CPR) * 8, t = m & (SEQ - 1);
        float v[8], gt[8];
#pragma unroll
        for (int e = 0; e < 8; ++e) { v[e] = cb[c0 + e]; gt[e] = cb[D_FF + c0 + e]; }
#pragma unroll
        for (int k = 0; k < 3; ++k) { const int dt = 2 - k; if (t >= dt) { float a[8], b[8]; const h16* r = U + (size_t)(m - dt) * D_FF2; ld8(r + c0, a); ld8(r + D_FF + c0, b);
#pragma unroll
                for (int e = 0; e < 8; ++e) { v[e] += cw[k * D_FF2 + c0 + e] * a[e]; gt[e] += cw[k * D_FF2 + D_FF + c0 + e] * b[e]; } } }
        float o[8];
#pragma unroll
        for (int e = 0; e < 8; ++e) o[e] = gt[e] / (1.0f + __expf(-gt[e])) * v[e];
        u32x4 w; w.x = pkh(o[0], o[1]); w.y = pkh(o[2], o[3]); w.z = pkh(o[4], o[5]); w.w = pkh(o[6], o[7]);
        *(u32x4*)(HID + (size_t)m * D_FF + c0) = w;
    }
}

#define GRID_SYNC() do { __threadfence(); grid.sync(); } while (0)
__global__ void __launch_bounds__(NTHR, 2) mega_fwd(MegaArgs a_unused) {
    extern __shared__ __attribute__((aligned(16))) unsigned char lds_raw[];
    LAS unsigned char* L = (LAS unsigned char*)lds_raw;
    cg::grid_group grid = cg::this_grid();
    KArgs kp0 = (KArgs)__builtin_amdgcn_kernarg_segment_ptr();
#define KP() ({ KArgs p_ = kp0; asm volatile("" : "+s"(p_)); p_; })
#define WSP() (KP()->ws)
#define OUTP() (KP()->out)
#define INP(i) (KP()->in[i])
    prep_phase(KP(), L);
    GRID_SYNC();
#pragma nounroll
    for (int l = 0; l < DEPTH; ++l) {
        {
            pg8::Gemm g{(h16*)(WSP() + WS_X16), (const h16*)(WSP() + WS_WIN) + (size_t)l * IN_PAD * D_MODEL, D_MODEL, D_MODEL, D_MODEL};
            pg8::StaticOrder S; { PHASE_IDS(); S.init(MTOK, IN_PAD, grd_, bid_); }
            pg8::EpiInProj E{(h16*)(WSP() + WS_P3), (h16*)(WSP() + WS_Q), (h16*)(WSP() + WS_KV), (h16*)(WSP() + WS_GATES)};
            pg8::gemm_phase<pg8::EpiInProj, pg8::StaticOrder, true>(L, g, S, E);
        }
        GRID_SYNC();
        elem_phase(WSP(), INP(2) + (size_t)l * 3 * CONV_W, INP(8) + (size_t)l * 1024);
        GRID_SYNC();
        {
            pg8::Gemm g{(const h16*)(WSP() + WS_KV), (const h16*)(WSP() + WS_CW1) + (size_t)l * 2 * CMP_H * CMP_K, 1024, CMP_K, CMP_K};
            pg8::CmpOrder S; { PHASE_IDS(); S.G = grd_; S.c = bid_; }
            pg8::EpiCmpH E{(h16*)(WSP() + WS_HCMP), (const float*)(WSP() + WS_CB1) + (size_t)l * 2 * CMP_H};
            pg8::gemm_phase<pg8::EpiCmpH, pg8::CmpOrder, true>(L, g, S, E);
        }
        GRID_SYNC();
        cmp2_phase(WSP(), INP(6) + (size_t)l * 2 * CMP_H * 64, INP(7) + (size_t)l * 2 * 64);
        GRID_SYNC();
        {   att::Ptrs P{(const h16*)(WSP() + WS_Q), (const h16*)(WSP() + WS_KV), (const h16*)(WSP() + WS_KCMP), (const h16*)(WSP() + WS_GATES), (h16*)(WSP() + WS_MIXED), INP(8) + (size_t)l * 1024};
            att::attn_phase(P, (LAS char*)L); }
        GRID_SYNC();
        {
            pg8::Gemm g{(const h16*)(WSP() + WS_MIXED), (const h16*)(WSP() + WS_WOUT) + (size_t)l * D_MODEL * D_MODEL, D_MODEL, D_MODEL, D_MODEL};
            pg8::StaticOrder S; { PHASE_IDS(); S.init(MTOK, D_MODEL, grd_, bid_); }
            pg8::EpiResid E{l == 0 ? INP(0) : OUTP(), OUTP(), D_MODEL};
            pg8::gemm_phase<pg8::EpiResid, pg8::StaticOrder, true>(L, g, S, E);
        }
        GRID_SYNC();
        ln_phase(OUTP(), (h16*)(WSP() + WS_X16), INP(10) + (size_t)l * 1024, INP(11) + (size_t)l * 1024);
        GRID_SYNC();
#pragma nounroll
        for (int hf = 0; hf < 2; ++hf) {
            const size_t r0 = (size_t)hf * (MTOK / 2);
            {   pg8::Gemm g{(h16*)(WSP() + WS_X16) + r0 * D_MODEL, (const h16*)(WSP() + WS_WUP) + (size_t)l * D_FF2 * D_MODEL, D_MODEL, D_MODEL, D_MODEL};
                pg8::StaticOrder S; { PHASE_IDS(); S.init(MTOK / 2, D_FF2, grd_, bid_); }
                pg8::EpiH16 E{(h16*)(WSP() + WS_U), D_FF2};
                pg8::gemm_phase<pg8::EpiH16, pg8::StaticOrder, true>(L, g, S, E); }
            GRID_SYNC();
            ffnact_phase((const h16*)(WSP() + WS_U), (h16*)(WSP() + WS_HID), INP(13) + (size_t)l * 3 * D_FF2, INP(14) + (size_t)l * D_FF2, MTOK / 2);
            GRID_SYNC();
            {   pg8::Gemm g{(const h16*)(WSP() + WS_HID), (const h16*)(WSP() + WS_WDN) + (size_t)l * D_MODEL * D_FF, D_FF, D_FF, D_FF};
                pg8::StaticOrder S; { PHASE_IDS(); S.init(MTOK / 2, D_MODEL, grd_, bid_); }
                float* o_ = OUTP() + r0 * D_MODEL; pg8::EpiResid E{o_, o_, D_MODEL};
                pg8::gemm_phase<pg8::EpiResid, pg8::StaticOrder, true>(L, g, S, E); }
            GRID_SYNC();
        }
        ln_phase(OUTP(), (h16*)(WSP() + WS_X16), INP(16) + (size_t)l * 1024, INP(17) + (size_t)l * 1024);
        if (l + 1 < DEPTH) GRID_SYNC();
    }
}

constexpr int MEGA_LDS = 147456;
extern "C" void kernel_launch(void* const* d_in, const int* in_sizes, int n_in, void* d_out, int out_size, void* d_ws, size_t ws_size, hipStream_t stream) {
    static int grid = 0;
    if (grid == 0) {
        if (n_in != 18 || in_sizes[0] != MTOK * D_MODEL || out_size != MTOK * D_MODEL || ws_size < WS_END) { fprintf(stderr, "kernel_launch: unexpected shapes (n_in %d, ws %zu)\n", n_in, ws_size); grid = -1; return; }
        int dev = 0, cus = 0, per_cu = 0;
        (void)hipGetDevice(&dev); (void)hipDeviceGetAttribute(&cus, hipDeviceAttributeMultiprocessorCount, dev);
        (void)hipFuncSetAttribute((const void*)mega_fwd, hipFuncAttributeMaxDynamicSharedMemorySize, MEGA_LDS);
        (void)hipOccupancyMaxActiveBlocksPerMultiprocessor(&per_cu, (const void*)mega_fwd, NTHR, MEGA_LDS);
        if (per_cu < 1) { fprintf(stderr, "kernel_launch: occupancy query says %d blocks/CU\n", per_cu); per_cu = 1; }
        grid = cus;
        fprintf(stderr, "kernel_launch: grid %d (cus %d, per_cu %d)\n", grid, cus, per_cu);
    }
    if (grid < 0) return;
    MegaArgs a{}; for (int i = 0; i < 18; ++i) a.in[i] = (const float*)d_in[i]; a.out = (float*)d_out; a.ws = (unsigned char*)d_ws;
    void* args[] = {&a};
    hipError_t e = hipLaunchCooperativeKernel((const void*)mega_fwd, dim3(grid), dim3(NTHR), args, MEGA_LDS, stream);
    if (e != hipSuccess) fprintf(stderr, "cooperative launch failed: %s (grid %d)\n", hipGetErrorString(e), grid);
}
```

```cpp
#include <hip/hip_runtime.h>
#include <hip/hip_cooperative_groups.h>
namespace cg = cooperative_groups;
#include <cstdio>
#include <cstdint>

constexpr int D_MODEL = 1024, BATCH = 8, SEQ = 4096, DEPTH = 2, HD = 64;
constexpr int MTOK = BATCH * SEQ;
constexpr int CONV_W = 512, NQH = 8, NG = 2, RPG = 4;
constexpr int IN_COLS = 2840, IN_PAD = 3072;
constexpr int D_FF = 2816, D_FF2 = 5632;
constexpr int NCMP = 255, NSEL = 64, TOPK = 16, WIN = 512;
constexpr float ALPHA = 1.41421356237309515f;
constexpr int CMP_K = 2048, CMP_H = 256;

typedef _Float16 h16;
typedef h16 h16x8 __attribute__((ext_vector_type(8)));
typedef h16 h16x4 __attribute__((ext_vector_type(4)));
typedef h16 h16x2 __attribute__((ext_vector_type(2)));
typedef short s16x8 __attribute__((ext_vector_type(8)));
typedef float f32x4 __attribute__((ext_vector_type(4)));
typedef float f32x2 __attribute__((ext_vector_type(2)));
typedef unsigned u32x4 __attribute__((ext_vector_type(4)));
typedef unsigned u32x2 __attribute__((ext_vector_type(2)));
#define LAS __attribute__((address_space(3)))

#define PHASE_IDS() int tid_ = threadIdx.x, bid_ = blockIdx.x, grd_ = gridDim.x; asm volatile("" : "+v"(tid_), "+s"(bid_), "+s"(grd_))
__device__ __forceinline__ unsigned pkh(float lo, float hi) { h16x2 v = {(h16)lo, (h16)hi}; return __builtin_bit_cast(unsigned, v); }

constexpr size_t MiB = 1u << 20;
constexpr size_t WS_ROPE = 1 * MiB;
constexpr size_t WS_CB1 = 1 * MiB + 512 * 1024;
constexpr size_t WS_WIN = 2 * MiB;
constexpr size_t WS_WOUT = 14 * MiB;
constexpr size_t WS_WUP = 18 * MiB;
constexpr size_t WS_WDN = 40 * MiB;
constexpr size_t WS_CW1 = 51 * MiB;
constexpr size_t WS_KCMP = 56 * MiB;
constexpr size_t WS_HCMP = 57 * MiB;
constexpr size_t WS_X16 = 64 * MiB;
constexpr size_t WS_P3 = 128 * MiB;
constexpr size_t WS_Q = 224 * MiB;
constexpr size_t WS_KV = 256 * MiB;
constexpr size_t WS_GATES = 304 * MiB;
constexpr size_t WS_MIXED = 306 * MiB;
constexpr size_t WS_U = 128 * MiB;
constexpr size_t WS_HID = 304 * MiB;
constexpr size_t WS_END = 400 * MiB;
constexpr size_t KV_CH = (size_t)MTOK * 64;

namespace pg8 {
constexpr int BM = 256, BK = 64, HALF = 128, HTB = HALF * BK * 2, STAGE_BYTES = 8 * HTB, NXCD = 8, WGM = 8;
__host__ __device__ __forceinline__ int lds_byte(int r, int c) { const int st = (r >> 4) * 2 + (c >> 5), rr = r & 15, cc = c & 31, ob = rr * 64 + cc * 2; return st * 1024 + (ob ^ (((ob >> 9) & 1) << 5)); }
__host__ __device__ __forceinline__ void stage_rc(int b, int& R, int& C) { const int st = b / 1024, sb = b % 1024, swz = sb ^ (((sb >> 9) & 1) << 5); R = (st >> 1) * 16 + swz / 64; C = (st & 1) * 32 + (swz % 64) / 2; }
__host__ __device__ __forceinline__ int perm32(int rho) { const int n = rho >> 4, i = rho & 15; return 8 * (i >> 2) + 4 * n + (i & 3); }

struct Unit { int pm, pn; };
struct Gemm { const h16* A; const h16* Bt; int lda, ldb, K; };

struct StaticOrder {
    int nM, nN, nwg, G, c;
    __host__ __device__ void init(int M, int N, int G_, int c_) { nM = M / BM; nN = N / BM; nwg = nM * nN; G = G_; c = c_; }
    __host__ __device__ bool next(int i, Unit& u) const {
        const long L = (long)i * G + c; if (L >= nwg) return false;
        int wgid = (int)L; { const int q = nwg / NXCD, r = nwg % NXCD, xcd = wgid % NXCD, off = wgid / NXCD; wgid = (xcd < r ? xcd * (q + 1) : r * (q + 1) + (xcd - r) * q) + off; }
        const int nig = WGM * nN, gid = wgid / nig, fm = gid * WGM, gsz = (nM - fm) < WGM ? (nM - fm) : WGM;
        u.pm = fm + ((wgid % nig) % gsz); u.pn = (wgid % nig) / gsz; return true;
    }
};
struct CmpOrder {
    int G, c;
    __host__ __device__ bool next(int i, Unit& u) const { const int L = i * G + c; if (L >= 32) return false; u.pm = L; u.pn = L >> 4; return true; }
};

template <class Epi, class Sched, bool ALIGN_EPI>
__device__ __forceinline__ void gemm_phase(LAS unsigned char* lds, const Gemm g, const Sched& S, const Epi& E) {
    int tid = threadIdx.x; asm volatile("" : "+v"(tid));
    const int wid = __builtin_amdgcn_readfirstlane(tid >> 6), lane = tid & 63, wr = wid >> 2, wc = wid & 3, fr = lane & 15, fq = lane >> 4;
    const int K = g.K, nt = K / BK;
    unsigned voffA[2], voffB[2];
#pragma unroll
    for (int i = 0; i < 2; ++i) { int R, C; stage_rc(tid * 16 + i * 8192, R, C); const int Rb = Epi::PERM ? ((R & ~31) + perm32(R & 31)) : R;
        voffA[i] = (unsigned)(R * g.lda + C) * 2u; voffB[i] = (unsigned)(Rb * g.ldb + C) * 2u; }
    const size_t kstep = (size_t)(BK * 2);
    const size_t hstepA = (size_t)HALF * g.lda * 2, hstepB = (size_t)HALF * g.ldb * 2;
    const size_t tstepA = 2 * hstepA, tstepB = 2 * hstepB;
    const unsigned ldsw = (unsigned)wid * 1024u;
    const int aoff = lds_byte(wr * 64 + fr, fq * 8), boff = lds_byte(wc * 32 + fr, fq * 8);
#define PG8_SA(b, h) (((b) * 2 + (h)) * HTB)
#define PG8_SB(b, h) ((4 + (b) * 2 + (h)) * HTB)
#define PG8_STAGE(bufoff, gbase, voff) do { _Pragma("unroll") for (int _i = 0; _i < 2; ++_i) \
        __builtin_amdgcn_global_load_lds((const unsigned*)((const char*)(gbase) + (voff)[_i]), (LAS unsigned*)(lds + (bufoff) + ldsw + _i * 8192), 16, 0, 0); } while (0)
#define PG8_LDA(dst, b, h) do { _Pragma("unroll") for (int m = 0; m < 4; ++m) _Pragma("unroll") for (int k = 0; k < 2; ++k) dst[m][k] = *(const LAS h16x8*)(lds + PG8_SA(b, h) + aoff + m * 2048 + k * 1024); } while (0)
#define PG8_LDB(dst, b, h) do { _Pragma("unroll") for (int n = 0; n < 2; ++n) _Pragma("unroll") for (int k = 0; k < 2; ++k) dst[n][k] = *(const LAS h16x8*)(lds + PG8_SB(b, h) + boff + n * 2048 + k * 1024); } while (0)
#define PG8_MMA(ai, bj, At, Bt) do { __builtin_amdgcn_s_setprio(1); _Pragma("unroll") for (int m = 0; m < 4; ++m) _Pragma("unroll") for (int n = 0; n < 2; ++n) _Pragma("unroll") for (int k = 0; k < 2; ++k) \
        acc[ai][bj][m][n] = __builtin_amdgcn_mfma_f32_16x16x32_f16(Bt[n][k], At[m][k], acc[ai][bj][m][n], 0, 0, 0); __builtin_amdgcn_s_setprio(0); } while (0)
#define PG8_WAIT_V(n) asm volatile("s_waitcnt vmcnt(" #n ")" ::: "memory")
#define PG8_WAIT_L(n) asm volatile("s_waitcnt lgkmcnt(" #n ")" ::: "memory")
#define PG8_BAR __builtin_amdgcn_s_barrier()
#define PG8_SCHED __builtin_amdgcn_sched_barrier(0)
    Unit cur, nxt; int ui = 0;
    if (!S.next(0, cur)) return;
    f32x4 acc[2][2][4][2];
#pragma unroll
    for (int a = 0; a < 2; ++a)
#pragma unroll
        for (int b = 0; b < 2; ++b)
#pragma unroll
            for (int m = 0; m < 4; ++m)
#pragma unroll
                for (int n = 0; n < 2; ++n) acc[a][b][m][n] = (f32x4){0.f, 0.f, 0.f, 0.f};
    h16x8 At[4][2], B0[2][2], B1[2][2];
    const char* cA = (const char*)g.A + (size_t)cur.pm * tstepA; const char* cB = (const char*)g.Bt + (size_t)cur.pn * tstepB;
    PG8_STAGE(PG8_SB(0, 0), cB, voffB); PG8_STAGE(PG8_SB(0, 1), cB + hstepB, voffB); PG8_STAGE(PG8_SA(0, 0), cA, voffA); PG8_STAGE(PG8_SA(0, 1), cA + hstepA, voffA);
    if (wr == 1) PG8_BAR;
    PG8_WAIT_V(2); PG8_BAR;
    PG8_STAGE(PG8_SB(1, 0), cB + kstep, voffB); PG8_STAGE(PG8_SA(1, 0), cA + kstep, voffA); PG8_STAGE(PG8_SB(1, 1), cB + hstepB + kstep, voffB);
    PG8_WAIT_V(6); PG8_BAR;
    for (;;) {
        const bool has_next = S.next(ui + 1, nxt);
        const char* nA = has_next ? (const char*)g.A + (size_t)nxt.pm * tstepA : cA; const char* nB = has_next ? (const char*)g.Bt + (size_t)nxt.pn * tstepB : cB;
        for (int t = 0; t < nt; t += 2) {
            const bool last = (t == nt - 2);
            const char* a1 = cA + (size_t)(t + 1) * kstep;
            const char* a2 = last ? nA : cA + (size_t)(t + 2) * kstep; const char* b2 = last ? nB : cB + (size_t)(t + 2) * kstep;
            const char* a3 = a2 + kstep; const char* b3 = b2 + kstep;
            PG8_LDB(B0, 0, 0); PG8_LDB(B1, 0, 1); PG8_SCHED; PG8_LDA(At, 0, 0); PG8_STAGE(PG8_SA(1, 1), a1 + hstepA, voffA);
            PG8_WAIT_V(8); PG8_WAIT_L(0); PG8_BAR; PG8_MMA(0, 0, At, B0); PG8_MMA(0, 1, At, B1); PG8_BAR; PG8_SCHED;
            PG8_LDA(At, 0, 1); PG8_STAGE(PG8_SB(0, 0), b2, voffB); PG8_STAGE(PG8_SB(0, 1), b2 + hstepB, voffB); PG8_STAGE(PG8_SA(0, 0), a2, voffA);
            PG8_WAIT_V(8); PG8_WAIT_L(0); PG8_BAR; PG8_MMA(1, 0, At, B0); PG8_MMA(1, 1, At, B1); PG8_BAR; PG8_SCHED;
            PG8_LDB(B0, 1, 0); PG8_LDB(B1, 1, 1); PG8_SCHED; PG8_LDA(At, 1, 0); PG8_STAGE(PG8_SA(0, 1), a2 + hstepA, voffA);
            PG8_WAIT_V(8); PG8_WAIT_L(0); PG8_BAR; PG8_MMA(0, 0, At, B0); PG8_MMA(0, 1, At, B1); PG8_BAR; PG8_SCHED;
            PG8_LDA(At, 1, 1); PG8_STAGE(PG8_SB(1, 0), b3, voffB); PG8_STAGE(PG8_SB(1, 1), b3 + hstepB, voffB); PG8_STAGE(PG8_SA(1, 0), a3, voffA);
            PG8_WAIT_V(8); PG8_WAIT_L(0); PG8_BAR; PG8_MMA(1, 0, At, B0); PG8_MMA(1, 1, At, B1); PG8_BAR; PG8_SCHED;
        }
        if constexpr (ALIGN_EPI) { if (wr == 0) PG8_BAR; }
        E(acc, cur, wr, wc, fr, fq);
        if (!has_next) break;
#pragma unroll
        for (int a = 0; a < 2; ++a)
#pragma unroll
            for (int b = 0; b < 2; ++b)
#pragma unroll
                for (int m = 0; m < 4; ++m)
#pragma unroll
                    for (int n = 0; n < 2; ++n) acc[a][b][m][n] = (f32x4){0.f, 0.f, 0.f, 0.f};
        cur = nxt; cA = nA; cB = nB; ++ui;
        if constexpr (ALIGN_EPI) { if (wr == 1) PG8_BAR; }
    }
    PG8_WAIT_V(0);
    if constexpr (!ALIGN_EPI) { if (wr == 0) PG8_BAR; }
    PG8_BAR;
#undef PG8_SA
#undef PG8_SB
#undef PG8_STAGE
#undef PG8_LDA
#undef PG8_LDB
#undef PG8_MMA
#undef PG8_WAIT_V
#undef PG8_WAIT_L
#undef PG8_BAR
#undef PG8_SCHED
}

__device__ __forceinline__ u32x4 pack8(const f32x4 v0, const f32x4 v1) { u32x4 w; w.x = pkh(v0[0], v0[1]); w.y = pkh(v0[2], v0[3]); w.z = pkh(v1[0], v1[1]); w.w = pkh(v1[2], v1[3]); return w; }

struct EpiInProj {
    static constexpr bool PERM = true;
    h16 *P3, *Q, *KV, *GATES;
    __device__ __forceinline__ void operator()(const f32x4 (&acc)[2][2][4][2], const Unit& u, int wr, int wc, int fr, int fq) const {
        const int pn = u.pn; const int row0 = u.pm * BM + wr * 64 + fr;
#pragma unroll
        for (int ai = 0; ai < 2; ++ai)
#pragma unroll
            for (int m = 0; m < 4; ++m) { const size_t row = (size_t)(row0 + ai * HALF + m * 16);
#pragma unroll
                for (int bj = 0; bj < 2; ++bj) { const u32x4 w = pack8(acc[ai][bj][m][0], acc[ai][bj][m][1]);
                    if (pn < 6) *(u32x4*)(P3 + row * 1536 + pn * 256 + bj * 128 + wc * 32 + 8 * fq) = w;
                    else if (pn < 8) *(u32x4*)(Q + row * 512 + (pn - 6) * 256 + bj * 128 + wc * 32 + 8 * fq) = w;
                    else if (pn < 11) { const int ch = (pn - 8) * 4 + bj * 2 + (wc >> 1); *(u32x4*)(KV + (size_t)ch * KV_CH + row * 64 + (wc & 1) * 32 + 8 * fq) = w; }
                    else if (bj == 0 && wc == 0) *(u32x4*)(GATES + row * 32 + 8 * fq) = w; } }
    }
};
struct EpiH16 {
    static constexpr bool PERM = true;
    h16* O; int ldc;
    __device__ __forceinline__ void operator()(const f32x4 (&acc)[2][2][4][2], const Unit& u, int wr, int wc, int fr, int fq) const {
        const int row0 = u.pm * BM + wr * 64 + fr, col0 = u.pn * BM + wc * 32 + 8 * fq;
#pragma unroll
        for (int ai = 0; ai < 2; ++ai)
#pragma unroll
            for (int m = 0; m < 4; ++m) { h16* rowp = O + (size_t)(row0 + ai * HALF + m * 16) * ldc + col0;
#pragma unroll
                for (int bj = 0; bj < 2; ++bj) *(u32x4*)(rowp + bj * HALF) = pack8(acc[ai][bj][m][0], acc[ai][bj][m][1]); }
    }
};
struct EpiResid {
    static constexpr bool PERM = false;
    const float* res; float* out; int ldc;
    __device__ __forceinline__ void operator()(const f32x4 (&acc)[2][2][4][2], const Unit& u, int wr, int wc, int fr, int fq) const {
        const int row0 = u.pm * BM + wr * 64 + fr, col0 = u.pn * BM + wc * 32 + 4 * fq;
#pragma unroll
        for (int ai = 0; ai < 2; ++ai)
#pragma unroll
            for (int m = 0; m < 4; ++m) { const size_t off = (size_t)(row0 + ai * HALF + m * 16) * ldc + col0;
#pragma unroll
                for (int bj = 0; bj < 2; ++bj)
#pragma unroll
                    for (int n = 0; n < 2; ++n) { const f32x4 r = *(const f32x4*)(res + off + bj * HALF + n * 16); *(f32x4*)(out + off + bj * HALF + n * 16) = r * ALPHA + acc[ai][bj][m][n]; } }
    }
};
__device__ __forceinline__ float gelu_tanh(float x) {
    const float u = 0.7978845608028654f * (x + 0.044715f * x * x * x);
    const float e = __expf(2.0f * u);
    const float th = 1.0f - 2.0f / (e + 1.0f);
    return 0.5f * x * (1.0f + th);
}
struct EpiCmpH {
    static constexpr bool PERM = true;
    h16* H; const float* cb1;
    __device__ __forceinline__ void operator()(const f32x4 (&acc)[2][2][4][2], const Unit& u, int wr, int wc, int fr, int fq) const {
        const int row0 = u.pm * BM + wr * 64 + fr, col0 = wc * 32 + 8 * fq;
        f32x4 bv[2][2];
#pragma unroll
        for (int bj = 0; bj < 2; ++bj)
#pragma unroll
            for (int n = 0; n < 2; ++n) bv[bj][n] = *(const f32x4*)(cb1 + u.pn * 256 + col0 + bj * HALF + 4 * n);
#pragma unroll
        for (int ai = 0; ai < 2; ++ai)
#pragma unroll
            for (int m = 0; m < 4; ++m) { h16* rowp = H + (size_t)(row0 + ai * HALF + m * 16) * 256 + col0;
#pragma unroll
                for (int bj = 0; bj < 2; ++bj) { f32x4 v0 = acc[ai][bj][m][0] + bv[bj][0], v1 = acc[ai][bj][m][1] + bv[bj][1];
#pragma unroll
                    for (int e = 0; e < 4; ++e) { v0[e] = gelu_tanh(v0[e]); v1[e] = gelu_tanh(v1[e]); }
                    *(u32x4*)(rowp + bj * HALF) = pack8(v0, v1); } }
    }
};
}

constexpr int NTHR = 512, NWAVES = 8;
constexpr int GEMM_LDS = 131072 + 16384;

__device__ __forceinline__ void transpose_item(const float* W, int K, int N, h16* WT, LAS float* scr, int item, int nblk, int lane) {
    const int kb = item / nblk, nb = item % nblk, k0 = 64 * kb, n0 = 32 * nb;
#pragma unroll 8
    for (int i = 0; i < 32; ++i) { const int kk = 2 * i + (lane >> 5); const int n = n0 + (lane & 31); scr[kk * 33 + (lane & 31)] = (n < N) ? W[(size_t)(k0 + kk) * N + n] : 0.f; }
    asm volatile("s_waitcnt lgkmcnt(0)" ::: "memory");
    const int c = lane & 7;
#pragma unroll
    for (int j = 0; j < 4; ++j) { const int n = (lane >> 3) + 8 * j; const LAS float* s = scr + (8 * c) * 33 + n;
        u32x4 o; o.x = pkh(s[0 * 33], s[1 * 33]); o.y = pkh(s[2 * 33], s[3 * 33]); o.z = pkh(s[4 * 33], s[5 * 33]); o.w = pkh(s[6 * 33], s[7 * 33]);
        *(u32x4*)(WT + (size_t)(n0 + n) * K + k0 + 8 * c) = o; }
    asm volatile("s_waitcnt lgkmcnt(0)" ::: "memory");
}
struct MegaArgs { const float* in[18]; float* out; unsigned char* ws; };
typedef const __attribute__((address_space(4))) MegaArgs* KArgs;
__device__ __forceinline__ void prep_phase(KArgs ap, LAS unsigned char* lds) {
#define a (*ap)
    PHASE_IDS(); const int tid = tid_, lane = tid & 63, wave = tid >> 6;
    LAS float* scr = (LAS float*)lds + wave * 64 * 33;
    const int gw = bid_ * NWAVES + wave, NGW = grd_ * NWAVES;
    unsigned char* ws = a.ws;
    constexpr int I_IN = 16 * 96, I_OUT = 16 * 32, I_UP = 16 * 176, I_DN = 44 * 32, I_C1 = 32 * 8;
    constexpr int PER_L = I_IN + I_OUT + I_UP + I_DN + 2 * I_C1;
    for (int it = gw; it < DEPTH * PER_L; it += NGW) {
        const int l = it / PER_L; int r = it % PER_L;
        if (r < I_IN) { transpose_item(a.in[1] + (size_t)l * D_MODEL * IN_COLS, D_MODEL, IN_COLS, (h16*)(ws + WS_WIN) + (size_t)l * IN_PAD * D_MODEL, scr, r, 96, lane); continue; } r -= I_IN;
        if (r < I_OUT) { transpose_item(a.in[9] + (size_t)l * D_MODEL * D_MODEL, D_MODEL, D_MODEL, (h16*)(ws + WS_WOUT) + (size_t)l * D_MODEL * D_MODEL, scr, r, 32, lane); continue; } r -= I_OUT;
        if (r < I_UP) { transpose_item(a.in[12] + (size_t)l * D_MODEL * D_FF2, D_MODEL, D_FF2, (h16*)(ws + WS_WUP) + (size_t)l * D_FF2 * D_MODEL, scr, r, 176, lane); continue; } r -= I_UP;
        if (r < I_DN) { transpose_item(a.in[15] + (size_t)l * D_FF * D_MODEL, D_FF, D_MODEL, (h16*)(ws + WS_WDN) + (size_t)l * D_MODEL * D_FF, scr, r, 32, lane); continue; } r -= I_DN;
        const int kv = r / I_C1; r %= I_C1;
        transpose_item(a.in[4] + (size_t)(l * 2 + kv) * CMP_K * CMP_H, CMP_K, CMP_H, (h16*)(ws + WS_CW1) + (size_t)(l * 2 + kv) * CMP_H * CMP_K, scr, r, 8, lane);
    }
    const float* x = a.in[0]; h16* x16 = (h16*)(ws + WS_X16);
    for (int m = gw; m < MTOK; m += NGW) {
        const f32x4* xr = (const f32x4*)(x + (size_t)m * D_MODEL) + lane; u32x2* o = (u32x2*)(x16 + (size_t)m * D_MODEL) + lane;
#pragma unroll
        for (int j = 0; j < 4; ++j) { const f32x4 v = xr[64 * j]; u32x2 w; w.x = pkh(v[0], v[1]); w.y = pkh(v[2], v[3]); o[64 * j] = w; }
    }
    {
        float* rope = (float*)(ws + WS_ROPE);
        const int gt = bid_ * NTHR + tid, NT = grd_ * NTHR;
        for (int i = gt; i < SEQ * 8; i += NT) { const int t = i >> 3, j = i & 7;
            const float inv = (float)pow(500000.0, -(double)j / 8.0);
            const float ang = (float)t * inv;
            rope[t * 16 + j] = (float)cos((double)ang); rope[t * 16 + 8 + j] = (float)sin((double)ang); }
    }
    {
        float* cb1 = (float*)(ws + WS_CB1);
        for (int i = gw; i < DEPTH * 2 * CMP_H; i += NGW) { const int lk = i / CMP_H, n = i % CMP_H;
            const float* pe = a.in[3] + (size_t)lk * CMP_K; const float* w1 = a.in[4] + (size_t)lk * CMP_K * CMP_H;
            float s = 0.f;
#pragma unroll 8
            for (int k = lane; k < CMP_K; k += 64) s += pe[k] * w1[(size_t)k * CMP_H + n];
#pragma unroll
            for (int o = 1; o < 64; o <<= 1) s += __shfl_xor(s, o);
            if (lane == 0) cb1[i] = s + a.in[5][i]; }
    }
#undef a
}

__device__ __forceinline__ void ld8(const h16* p, float (&v)[8]) { const h16x8 h = *(const h16x8*)p;
#pragma unroll
    for (int i = 0; i < 8; ++i) v[i] = (float)h[i]; }
__device__ __forceinline__ void elem_phase(unsigned char* ws, const float* convw  , const float* hng  ) {
    PHASE_IDS(); const int lane = tid_ & 63, wave = tid_ >> 6;
    const int gw = bid_ * NWAVES + wave, NGW = grd_ * NWAVES;
    const h16* P3 = (const h16*)(ws + WS_P3); h16* MIX = (h16*)(ws + WS_MIXED);
    h16* Q = (h16*)(ws + WS_Q); h16* KV = (h16*)(ws + WS_KV); const float* rope = (const float*)(ws + WS_ROPE);
    const int c0 = lane * 8;
    float w0[8], w1[8], w2[8], gg[8];
#pragma unroll
    for (int i = 0; i < 8; ++i) { w0[i] = convw[c0 + i]; w1[i] = convw[512 + c0 + i]; w2[i] = convw[1024 + c0 + i]; gg[i] = hng[c0 + i]; }
    for (int m = gw; m < MTOK; m += NGW) {
        const int t = m & (SEQ - 1);
        const h16* r0 = P3 + (size_t)m * 1536;
        float bg[8], z0[8], z1[8], z2[8], a_[8], b_[8];
        ld8(r0 + c0, bg);
        ld8(r0 + 512 + c0, a_); ld8(r0 + 1024 + c0, b_);
#pragma unroll
        for (int i = 0; i < 8; ++i) z2[i] = a_[i] * b_[i];
        if (t >= 1) { ld8(r0 - 1536 + 512 + c0, a_); ld8(r0 - 1536 + 1024 + c0, b_);
#pragma unroll
            for (int i = 0; i < 8; ++i) z1[i] = a_[i] * b_[i]; } else {
#pragma unroll
            for (int i = 0; i < 8; ++i) z1[i] = 0.f; }
        if (t >= 2) { ld8(r0 - 3072 + 512 + c0, a_); ld8(r0 - 3072 + 1024 + c0, b_);
#pragma unroll
            for (int i = 0; i < 8; ++i) z0[i] = a_[i] * b_[i]; } else {
#pragma unroll
            for (int i = 0; i < 8; ++i) z0[i] = 0.f; }
        float y[8]; float ss = 0.f;
#pragma unroll
        for (int i = 0; i < 8; ++i) { y[i] = bg[i] * (w0[i] * z0[i] + w1[i] * z1[i] + w2[i] * z2[i]); ss += y[i] * y[i]; }
        ss += __shfl_xor(ss, 1); ss += __shfl_xor(ss, 2); ss += __shfl_xor(ss, 4);
        const float rs = 1.0f / sqrtf(ss * (1.0f / 64.0f) + 1e-6f);
        u32x4 o; o.x = pkh(y[0] * rs * gg[0], y[1] * rs * gg[1]); o.y = pkh(y[2] * rs * gg[2], y[3] * rs * gg[3]); o.z = pkh(y[4] * rs * gg[4], y[5] * rs * gg[5]); o.w = pkh(y[6] * rs * gg[6], y[7] * rs * gg[7]);
        *(u32x4*)(MIX + (size_t)m * 1024 + c0) = o;
        if (lane < 14) {
            h16* p;
            if (lane < 8) p = Q + (size_t)m * 512 + lane * 64;
            else { const int k = lane - 8; const int ch = (k >> 1) * 4 + (k & 1); p = KV + (size_t)ch * KV_CH + (size_t)m * 64; }
            float x1[8], x2[8]; ld8(p, x1); ld8(p + 8, x2);
            const float* cs = rope + t * 16;
            float o1[8], o2[8];
#pragma unroll
            for (int j = 0; j < 8; ++j) { const float c = cs[j], s = cs[8 + j]; o1[j] = x1[j] * c - x2[j] * s; o2[j] = x2[j] * c + x1[j] * s; }
            u32x4 a; a.x = pkh(o1[0], o1[1]); a.y = pkh(o1[2], o1[3]); a.z = pkh(o1[4], o1[5]); a.w = pkh(o1[6], o1[7]);
            u32x4 b; b.x = pkh(o2[0], o2[1]); b.y = pkh(o2[2], o2[3]); b.z = pkh(o2[4], o2[5]); b.w = pkh(o2[6], o2[7]);
            *(u32x4*)p = a; *(u32x4*)(p + 8) = b;
        }
    }
}

__device__ __forceinline__ void cmp2_phase(unsigned char* ws, const float* w2  , const float* b2  ) {
    PHASE_IDS(); const int lane = tid_ & 63, wave = tid_ >> 6;
    const int gw = bid_ * NWAVES + wave, NGW = grd_ * NWAVES;
    const h16* H = (const h16*)(ws + WS_HCMP); h16* KC = (h16*)(ws + WS_KCMP);
    for (int r = gw; r < 8192; r += NGW) {
        const int ch = r >> 11, b = (r >> 8) & 7, c = r & 255, kv = ch >> 1, g = ch & 1;
        float s = b2[kv * 64 + lane];
        const h16* hr = H + (size_t)r * 256; const float* w = w2 + (size_t)kv * 256 * 64 + lane;
        for (int j = 0; j < 256; ++j) s += (float)hr[j] * w[j * 64];
        if (c == 255) s = 0.f;
        KC[((size_t)((kv * BATCH + b) * NG + g) * 256 + c) * 64 + lane] = (h16)s;
    }
}

namespace att {
typedef float f32x16 __attribute__((ext_vector_type(16)));
typedef short v4i16 __attribute__((ext_vector_type(4)));
constexpr float C2 = 0.125f * 1.4426950408889634f;
constexpr float NEGB = -1e30f, MINIT = -1e20f, THR = 8.0f;
constexpr int L_K = 0, L_V = 16384, L_WS = 32768, L_SG = 34816, L_SEL = 37888, L_IMP = 38912, OST_PITCH = 68, L_END = L_IMP + 8 * 32 * OST_PITCH * 4;
static_assert(L_END <= 131072, "attention LDS");

__device__ __forceinline__ int crow(int r, int hi) { return (r & 3) + 8 * (r >> 2) + 4 * hi; }
__device__ __forceinline__ void glds16(const void* gsrc, unsigned lds_dst) { unsigned keep;
    asm volatile("s_mov_b32 %0, m0\n\ts_mov_b32 m0, %2\n\ts_nop 0\n\tglobal_load_lds_dwordx4 %1, off\n\ts_mov_b32 m0, %0" : "=&s"(keep) : "v"(gsrc), "s"(lds_dst) : "memory"); }
#define ATT_WAIT_BAR(N) asm volatile("s_waitcnt vmcnt(" #N ") lgkmcnt(0)\n\ts_barrier" ::: "memory")
__device__ __forceinline__ float hmax2(float m) { auto rr = __builtin_amdgcn_permlane32_swap(__float_as_uint(m), __float_as_uint(m), false, false); return fmaxf(__uint_as_float(rr[0]), __uint_as_float(rr[1])); }
__device__ __forceinline__ float hsum2(float m) { auto rr = __builtin_amdgcn_permlane32_swap(__float_as_uint(m), __float_as_uint(m), false, false); return __uint_as_float(rr[0]) + __uint_as_float(rr[1]); }
__device__ __forceinline__ float rowmax(const f32x16& p0, const f32x16& p1) {
    float a = fmaxf(p0[0], p1[0]);
#pragma unroll
    for (int r = 1; r < 16; ++r) a = fmaxf(a, fmaxf(p0[r], p1[r]));
    return hmax2(a);
}
__device__ __forceinline__ void qkt(f32x16& p0, f32x16& p1, const LAS char* kslot, const h16x8 (&qr)[4], float cinit, int r32, int hi) {
    f32x16 c;
#pragma unroll
    for (int r = 0; r < 16; ++r) c[r] = cinit;
    const LAS char* kb = kslot + hi * 1024 + r32 * 16;
#pragma unroll
    for (int d0 = 0; d0 < 4; ++d0) {
        const h16x8 b0 = *(const LAS h16x8*)(kb + d0 * 2048), b1 = *(const LAS h16x8*)(kb + d0 * 2048 + 512);
        if (d0 == 0) { p0 = __builtin_amdgcn_mfma_f32_32x32x16_f16(b0, qr[0], c, 0, 0, 0); p1 = __builtin_amdgcn_mfma_f32_32x32x16_f16(b1, qr[0], c, 0, 0, 0); }
        else { p0 = __builtin_amdgcn_mfma_f32_32x32x16_f16(b0, qr[d0], p0, 0, 0, 0); p1 = __builtin_amdgcn_mfma_f32_32x32x16_f16(b1, qr[d0], p1, 0, 0, 0); }
    }
}
__device__ __forceinline__ void mask_range(f32x16& p0, f32x16& p1, int lo, int hb, int hi) {
#pragma unroll
    for (int r = 0; r < 16; ++r) { const int k = crow(r, hi); if (k < lo || k > hb) p0[r] = NEGB; if (k + 32 < lo || k + 32 > hb) p1[r] = NEGB; }
}
__device__ __forceinline__ h16x8 vfrag(const LAS char* p) {
    const v4i16 lo = __builtin_amdgcn_ds_read_tr16_b64_v4i16((LAS v4i16*)p), hi = __builtin_amdgcn_ds_read_tr16_b64_v4i16((LAS v4i16*)(p + 512));
    typedef short s16x8_t __attribute__((ext_vector_type(8)));
    const s16x8_t v = {lo[0], lo[1], lo[2], lo[3], hi[0], hi[1], hi[2], hi[3]};
    return __builtin_bit_cast(h16x8, v);
}
__device__ __forceinline__ void pv(f32x16 (&o)[2], const LAS char* vp, const f32x16& p0, const f32x16& p1) {
    u32x4 w[4];
#pragma unroll
    for (int i = 0; i < 4; ++i) { w[0][i] = pkh(p0[2 * i], p0[2 * i + 1]); w[1][i] = pkh(p0[8 + 2 * i], p0[9 + 2 * i]); w[2][i] = pkh(p1[2 * i], p1[2 * i + 1]); w[3][i] = pkh(p1[8 + 2 * i], p1[9 + 2 * i]); }
#pragma unroll
    for (int d0 = 0; d0 < 2; ++d0)
#pragma unroll
        for (int ks = 0; ks < 4; ++ks) o[d0] = __builtin_amdgcn_mfma_f32_32x32x16_f16(__builtin_bit_cast(h16x8, w[ks]), vfrag(vp + d0 * 4096 + ks * 1024), o[d0], 0, 0, 0);
}
template <bool HAS_O>
__device__ __forceinline__ void sm_step(f32x16& p0, f32x16& p1, float& mref, float& l, f32x16 (&o)[2], LAS float* wsf, int r32, int hi) {
    const float rm = rowmax(p0, p1);
    if (__any(rm > mref + THR)) {
        const float mn = fmaxf(mref, rm), al = __builtin_amdgcn_exp2f(mref - mn);
        l *= al; mref = mn;
        if (HAS_O) {
            if (hi == 0) wsf[r32] = al;
            asm volatile("s_waitcnt lgkmcnt(0)" ::: "memory");
#pragma unroll
            for (int r = 0; r < 16; ++r) { const float a = wsf[crow(r, hi)]; o[0][r] *= a; o[1][r] *= a; }
        }
    }
    float s = 0.f;
#pragma unroll
    for (int r = 0; r < 16; ++r) { p0[r] = __builtin_amdgcn_exp2f(p0[r] - mref); p1[r] = __builtin_amdgcn_exp2f(p1[r] - mref); s += p0[r] + p1[r]; }
    l += s;
}

struct Ptrs { const h16* Q; const h16* KV; const h16* KCMP; const h16* GT; h16* MIX; const float* hng; };

__device__ __forceinline__ void attn_unit(const Ptrs& P, int b, int g, int qt, LAS char* shm) {
    PHASE_IDS();
    const int tid = tid_, lane = tid & 63, r32 = lane & 31, hi = lane >> 5, wid = __builtin_amdgcn_readfirstlane(tid >> 6);
    const int hr = wid >> 1, qh = wid & 1, hd = g * 4 + hr;
    const int m0 = b * SEQ + 64 * qt, ql = 32 * qh + r32, tq = 64 * qt + ql;
    const unsigned lds0 = (unsigned)(uintptr_t)shm;
    LAS float* wsf = (LAS float*)(shm + L_WS) + wid * 64;
    LAS float* SG = (LAS float*)(shm + L_SG);
    LAS unsigned long long* SELM = (LAS unsigned long long*)(shm + L_SEL);
    LAS float* IMPH = (LAS float*)(shm + L_IMP);
    const bool need_topk = qt >= 16;
    if (tid < 256) { const int q = tid & 63, rr = tid >> 6; const h16* gp = P.GT + (size_t)(m0 + q) * 32 + (g * 4 + rr) * 3;
#pragma unroll
        for (int j = 0; j < 3; ++j) SG[j * 256 + rr * 64 + q] = 1.0f / (1.0f + __expf(-(float)gp[j])); }
    if (need_topk) { LAS f32x4* z = (LAS f32x4*)IMPH;
#pragma unroll
        for (int i = 0; i < 8; ++i) z[tid + i * NTHR] = (f32x4){0.f, 0.f, 0.f, 0.f}; }
    h16x8 qr[4];
    { const h16* qp = P.Q + (size_t)(m0 + ql) * 512 + hd * 64 + hi * 8;
#pragma unroll
      for (int d0 = 0; d0 < 4; ++d0) { const h16x8 v = *(const h16x8*)(qp + d0 * 16); h16x8 s;
#pragma unroll
          for (int i = 0; i < 8; ++i) s[i] = (h16)((float)v[i] * C2);
          qr[d0] = s; } }
    const unsigned kdst = lds0 + L_K + wid * 1024, vdst = lds0 + L_V + wid * 1024;
    const size_t koff = (size_t)lane * 64 + wid * 8, voff = (size_t)(16 * (wid & 3) + (lane >> 2)) * 64 + (wid >> 2) * 32 + (lane & 3) * 8;
#define ATT_DMA(Kb, Vb, kt, slot) do { glds16((Kb) + (size_t)(kt) * 4096 + koff, (unsigned)__builtin_amdgcn_readfirstlane(kdst + (slot) * 8192)); \
                                       glds16((Vb) + (size_t)(kt) * 4096 + voff, (unsigned)__builtin_amdgcn_readfirstlane(vdst + (slot) * 8192)); } while (0)
    const LAS char* kbase = (const LAS char*)shm + L_K;
    const LAS char* vbase = (const LAS char*)shm + L_V + ((lane >> 4) & 1) * 32 + (lane & 3) * 8 + (4 * hi + ((lane & 15) >> 2)) * 64;
    f32x16 comb[2], o[2], p0, p1;
#pragma unroll
    for (int r = 0; r < 16; ++r) { comb[0][r] = 0.f; comb[1][r] = 0.f; }
    asm volatile("s_waitcnt vmcnt(0)" ::: "memory");
#define ATT_COMBINE(fval) do { if (hi == 0) wsf[32 + r32] = (fval); asm volatile("s_waitcnt lgkmcnt(0)" ::: "memory"); \
        _Pragma("unroll") for (int r = 0; r < 16; ++r) { const float f_ = wsf[32 + crow(r, hi)]; comb[0][r] += o[0][r] * f_; comb[1][r] += o[1][r] * f_; } } while (0)

    {
        const h16* Kb = P.KCMP + (size_t)((0 * BATCH + b) * NG + g) * 256 * 64; const h16* Vb = P.KCMP + (size_t)((1 * BATCH + b) * NG + g) * 256 * 64;
        const int nct = (qt >> 4) + 1;
        const int cmax = (tq >= 31) ? ((tq - 31) >> 4) : -1;
        float mref = MINIT, l = 0.f;
        ATT_DMA(Kb, Vb, 0, 0);
        for (int ct = 0; ct < nct; ++ct) {
            const int slot = ct & 1;
            if (ct + 1 < nct) { ATT_DMA(Kb, Vb, ct + 1, slot ^ 1); ATT_WAIT_BAR(2); } else { ATT_WAIT_BAR(0); }
            qkt(p0, p1, kbase + slot * 8192, qr, 0.f, r32, hi);
            mask_range(p0, p1, 0, cmax - 64 * ct, hi);
            sm_step<false>(p0, p1, mref, l, o, wsf, r32, hi);
            ATT_WAIT_BAR(0);
        }
        l = hsum2(l);
        const float il = (l > 0.f) ? 1.0f / l : 0.f;
#pragma unroll
        for (int r = 0; r < 16; ++r) { o[0][r] = 0.f; o[1][r] = 0.f; }
        ATT_DMA(Kb, Vb, 0, 0);
        for (int ct = 0; ct < nct; ++ct) {
            const int slot = ct & 1;
            if (ct + 1 < nct) { ATT_DMA(Kb, Vb, ct + 1, slot ^ 1); ATT_WAIT_BAR(2); } else { ATT_WAIT_BAR(0); }
            qkt(p0, p1, kbase + slot * 8192, qr, 0.f, r32, hi);
            mask_range(p0, p1, 0, cmax - 64 * ct, hi);
#pragma unroll
            for (int r = 0; r < 16; ++r) { p0[r] = __builtin_amdgcn_exp2f(p0[r] - mref) * il; p1[r] = __builtin_amdgcn_exp2f(p1[r] - mref) * il; }
            if (need_topk) {
                LAS float* iw = IMPH + (hr * 64 + ql) * 64 + 16 * ct + hi;
#pragma unroll
                for (int j = 0; j < 4; ++j) {
                    const float e0 = 0.5f * p0[4 * j + 3], a0 = p0[4 * j] + p0[4 * j + 1] + p0[4 * j + 2] + e0;
                    const float e1 = 0.5f * p1[4 * j + 3], a1 = p1[4 * j] + p1[4 * j + 1] + p1[4 * j + 2] + e1;
                    __hip_atomic_fetch_add(iw + 2 * j, a0, __ATOMIC_RELAXED, __HIP_MEMORY_SCOPE_WORKGROUP);
                    __hip_atomic_fetch_add(iw + 2 * j + 1, e0, __ATOMIC_RELAXED, __HIP_MEMORY_SCOPE_WORKGROUP);
                    __hip_atomic_fetch_add(iw + 8 + 2 * j, a1, __ATOMIC_RELAXED, __HIP_MEMORY_SCOPE_WORKGROUP);
                    if (16 * ct + 8 + 2 * j + hi + 1 < 64) __hip_atomic_fetch_add(iw + 8 + 2 * j + 1, e1, __ATOMIC_RELAXED, __HIP_MEMORY_SCOPE_WORKGROUP);
                }
            }
            pv(o, vbase + slot * 8192, p0, p1);
            ATT_WAIT_BAR(0);
        }
        ATT_COMBINE(SG[0 * 256 + hr * 64 + ql]);
    }
    if (need_topk) {
        const int s = lane; const bool cand = (s >= 1) && (s <= qt - 2); const bool forced = (s == 0) || (s == qt) || (s == qt - 1);
        for (int i = 0; i < 8; ++i) {
            const int q = wid * 8 + i;
            const float v = ((IMPH[(0 * 64 + q) * 64 + s] + IMPH[(1 * 64 + q) * 64 + s]) + IMPH[(2 * 64 + q) * 64 + s]) + IMPH[(3 * 64 + q) * 64 + s];
            const unsigned khi = cand ? __float_as_uint(v) : 0u, klo = cand ? (unsigned)(63 - s) : 0u;
            const unsigned long long my = ((unsigned long long)khi << 32) | klo;
            int rank = 0;
#pragma unroll
            for (int j = 0; j < 64; ++j) { const unsigned long long kj = ((unsigned long long)__builtin_amdgcn_readlane(khi, j) << 32) | (unsigned)__builtin_amdgcn_readlane(klo, j); rank += (kj > my) ? 1 : 0; }
            const unsigned long long mk = __ballot(forced || (cand && rank < TOPK - 3));
            if (lane == 0) SELM[q] = mk;
        }
    } else if (tid < 64) SELM[tid] = (2ull << qt) - 1ull;
    asm volatile("s_waitcnt lgkmcnt(0)\n\ts_barrier" ::: "memory");
    {
        const h16* Kb = P.KV + (size_t)(4 + g) * KV_CH + (size_t)b * SEQ * 64; const h16* Vb = P.KV + (size_t)(6 + g) * KV_CH + (size_t)b * SEQ * 64;
        const unsigned long long sel = SELM[ql];
        float mref = MINIT, l = 0.f;
#pragma unroll
        for (int r = 0; r < 16; ++r) { o[0][r] = 0.f; o[1][r] = 0.f; }
        ATT_DMA(Kb, Vb, 0, 0);
        for (int kb = 0; kb <= qt; ++kb) {
            const int slot = kb & 1;
            if (kb < qt) { ATT_DMA(Kb, Vb, kb + 1, slot ^ 1); ATT_WAIT_BAR(2); } else { ATT_WAIT_BAR(0); }
            qkt(p0, p1, kbase + slot * 8192, qr, ((sel >> kb) & 1ull) ? 0.f : NEGB, r32, hi);
            if (kb == qt) mask_range(p0, p1, 0, ql, hi);
            sm_step<true>(p0, p1, mref, l, o, wsf, r32, hi);
            pv(o, vbase + slot * 8192, p0, p1);
            ATT_WAIT_BAR(0);
        }
        l = hsum2(l);
        ATT_COMBINE(SG[1 * 256 + hr * 64 + ql] * ((l > 0.f) ? 1.0f / l : 0.f));
    }
    {
        const h16* Kb = P.KV + (size_t)(8 + g) * KV_CH + (size_t)b * SEQ * 64; const h16* Vb = P.KV + (size_t)(10 + g) * KV_CH + (size_t)b * SEQ * 64;
        const int k0 = (qt >= 8) ? qt - 8 : 0;
        float mref = MINIT, l = 0.f;
#pragma unroll
        for (int r = 0; r < 16; ++r) { o[0][r] = 0.f; o[1][r] = 0.f; }
        ATT_DMA(Kb, Vb, k0, 0);
        for (int kb = k0; kb <= qt; ++kb) {
            const int slot = (kb - k0) & 1;
            if (kb < qt) { ATT_DMA(Kb, Vb, kb + 1, slot ^ 1); ATT_WAIT_BAR(2); } else { ATT_WAIT_BAR(0); }
            qkt(p0, p1, kbase + slot * 8192, qr, 0.f, r32, hi);
            if (kb == qt) mask_range(p0, p1, 0, ql, hi);
            else if (kb == qt - 8) mask_range(p0, p1, ql + 1, 63, hi);
            sm_step<true>(p0, p1, mref, l, o, wsf, r32, hi);
            pv(o, vbase + slot * 8192, p0, p1);
            ATT_WAIT_BAR(0);
        }
        l = hsum2(l);
        ATT_COMBINE(SG[2 * 256 + hr * 64 + ql] * ((l > 0.f) ? 1.0f / l : 0.f));
    }
    {
        LAS float* ost = (LAS float*)(shm + L_IMP) + wid * 32 * OST_PITCH;
#pragma unroll
        for (int r = 0; r < 16; ++r) { ost[crow(r, hi) * OST_PITCH + r32] = comb[0][r]; ost[crow(r, hi) * OST_PITCH + 32 + r32] = comb[1][r]; }
        asm volatile("s_waitcnt lgkmcnt(0)" ::: "memory");
        const int row = lane >> 1, half = lane & 1;
        f32x4 v[8]; float ss = 0.f;
#pragma unroll
        for (int i = 0; i < 8; ++i) { v[i] = *(const LAS f32x4*)(ost + row * OST_PITCH + half * 32 + 4 * i); ss += (v[i][0] * v[i][0] + v[i][1] * v[i][1]) + (v[i][2] * v[i][2] + v[i][3] * v[i][3]); }
        ss += __shfl_xor(ss, 1);
        const float rs = 1.0f / sqrtf(ss * (1.0f / 64.0f) + 1e-6f);
        const float* gp = P.hng + 512 + hd * 64 + half * 32;
        h16* op = P.MIX + (size_t)(m0 + 32 * qh + row) * 1024 + 512 + hd * 64 + half * 32;
#pragma unroll
        for (int i = 0; i < 4; ++i) { const f32x4 g0 = *(const f32x4*)(gp + 8 * i), g1 = *(const f32x4*)(gp + 8 * i + 4); const f32x4 a = v[2 * i] * rs * g0, c = v[2 * i + 1] * rs * g1;
            u32x4 w; w.x = pkh(a[0], a[1]); w.y = pkh(a[2], a[3]); w.z = pkh(c[0], c[1]); w.w = pkh(c[2], c[3]); *(u32x4*)(op + 8 * i) = w; }
    }
    asm volatile("s_waitcnt vmcnt(0) lgkmcnt(0)\n\ts_barrier" ::: "memory");
#undef ATT_DMA
#undef ATT_COMBINE
}

__device__ __forceinline__ void attn_phase(const Ptrs& P, LAS char* shm) {
    PHASE_IDS();
    const int G = grd_, bx = bid_;
    if (G == 256) {
        const int v = (bx & 7) * 32 + (bx >> 3);
        const int pair = v >> 4, s = v & 15;
        for (int i = 0; i < 4; ++i) { const int qt = (i == 0) ? 63 - s : (i == 1) ? 32 + s : (i == 2) ? 31 - s : s; attn_unit(P, pair >> 1, pair & 1, qt, shm); }
    } else {
        for (int u = bx; u < BATCH * NG * 64; u += G) attn_unit(P, u >> 7, (u >> 6) & 1, 63 - (u & 63), shm);
    }
}
}

__device__ __forceinline__ float wsum(float v) {
#pragma unroll
    for (int o = 1; o < 64; o <<= 1) v += __shfl_xor(v, o); return v; }
__device__ __forceinline__ void ln_phase(float* xio, h16* x16, const float* gam, const float* bet) {
    PHASE_IDS(); const int lane = tid_ & 63, wave = tid_ >> 6;
    const int gw = bid_ * NWAVES + wave, NGW = grd_ * NWAVES;
    f32x4 gv[4], bv[4];
#pragma unroll
    for (int j = 0; j < 4; ++j) { gv[j] = ((const f32x4*)gam)[lane + 64 * j]; bv[j] = ((const f32x4*)bet)[lane + 64 * j]; }
    for (int m = gw; m < MTOK; m += NGW) {
        f32x4* xr = (f32x4*)(xio + (size_t)m * D_MODEL) + lane;
        f32x4 v[4]; float s = 0.f;
#pragma unroll
        for (int j = 0; j < 4; ++j) { v[j] = xr[64 * j]; s += (v[j][0] + v[j][1]) + (v[j][2] + v[j][3]); }
        const float mean = wsum(s) * (1.0f / D_MODEL); float s2 = 0.f;
#pragma unroll
        for (int j = 0; j < 4; ++j) { v[j] = v[j] - mean; s2 += (v[j][0] * v[j][0] + v[j][1] * v[j][1]) + (v[j][2] * v[j][2] + v[j][3] * v[j][3]); }
        const float rstd = 1.0f / sqrtf(wsum(s2) * (1.0f / D_MODEL) + 1e-5f);
        u32x2* o16 = (u32x2*)(x16 + (size_t)m * D_MODEL) + lane;
#pragma unroll
        for (int j = 0; j < 4; ++j) { const f32x4 o = v[j] * rstd * gv[j] + bv[j]; xr[64 * j] = o; u32x2 w; w.x = pkh(o[0], o[1]); w.y = pkh(o[2], o[3]); o16[64 * j] = w; }
    }
}

__device__ __forceinline__ void ffnact_phase(const h16* U, h16* HID, const float* cw  , const float* cb  , int nrows) {
    PHASE_IDS(); const int tid = bid_ * NTHR + tid_, NT = grd_ * NTHR;
    constexpr int CPR = D_FF / 8;
    for (int i = tid; i < nrows * CPR; i += NT) {
        const int m = i / CPR, c0 = (i % CPR) * 8, t = m & (SEQ - 1);
        float v[8], gt[8];
#pragma unroll
        for (int e = 0; e < 8; ++e) { v[e] = cb[c0 + e]; gt[e] = cb[D_FF + c0 + e]; }
#pragma unroll
        for (int k = 0; k < 3; ++k) { const int dt = 2 - k; if (t >= dt) { float a[8], b[8]; const h16* r = U + (size_t)(m - dt) * D_FF2; ld8(r + c0, a); ld8(r + D_FF + c0, b);
#pragma unroll
                for (int e = 0; e < 8; ++e) { v[e] += cw[k * D_FF2 + c0 + e] * a[e]; gt[e] += cw[k * D_FF2 + D_FF + c0 + e] * b[e]; } } }
        float o[8];
#pragma unroll
        for (int e = 0; e < 8; ++e) o[e] = gt[e] / (1.0f + __expf(-gt[e])) * v[e];
        u32x4 w; w.x = pkh(o[0], o[1]); w.y = pkh(o[2], o[3]); w.z = pkh(o[4], o[5]); w.w = pkh(o[6], o[7]);
        *(u32x4*)(HID + (size_t)m * D_FF + c0) = w;
    }
}


#define XB_TMO      128
#define XB_XCNT(j)  (256  + 64 * (j))
#define XB_XSUB(j)  (1280 + 64 * (j))
#define XB_XGEN(j)  (2304 + 64 * (j))
#define XB_TOP      3328
#define XB_TOPGEN   3392
#define XCD_BAR_WORDS 3456
#define XB_SPIN_CAP (1u << 20)
__device__ __forceinline__ unsigned xb_ld(unsigned* p)              { return __hip_atomic_load(p, __ATOMIC_RELAXED, __HIP_MEMORY_SCOPE_AGENT); }
__device__ __forceinline__ unsigned xb_add(unsigned* p, unsigned v) { return __hip_atomic_fetch_add(p, v, __ATOMIC_RELAXED, __HIP_MEMORY_SCOPE_AGENT); }
__device__ __forceinline__ unsigned xb_xcc_id() { return (unsigned)__builtin_amdgcn_s_getreg((3 << 11) | 20) & 0xFu; }
#define XB_SPIN(cond, bar) do { unsigned _sp = 0; while (cond) { __builtin_amdgcn_s_sleep(1); \
    if ((++_sp & 255u) == 0u) { if (xb_ld(&(bar)[XB_TMO])) break; if (_sp > XB_SPIN_CAP) { atomicAdd(&(bar)[XB_TMO], 1u); break; } } } } while (0)
__device__ __forceinline__ void xcd_barrier_complete(unsigned* bar, unsigned x, unsigned& nloc, unsigned& nx) {
    const unsigned G = gridDim.x;
    unsigned sum, cnt, mine, sp = 0u;
    for (;;) {
        sum = 0u; cnt = 0u; mine = 0u;
#pragma unroll
        for (unsigned j = 0; j < 16; ++j) { const unsigned c = xb_ld(&bar[XB_XCNT(j)]); sum += c; cnt += (c > 0u) ? 1u : 0u; mine = (j == x) ? c : mine; }
        if (sum == G) break;
        __builtin_amdgcn_s_sleep(1);
        if ((++sp & 255u) == 0u) { if (xb_ld(&bar[XB_TMO])) break; if (sp > XB_SPIN_CAP) { atomicAdd(&bar[XB_TMO], 1u); break; } }
    }
    nloc = mine > 0u ? mine : 1u; nx = cnt > 0u ? cnt : 1u;
}
__device__ __forceinline__ void xcd_barrier(unsigned* bar, volatile LAS unsigned* st) {
    asm volatile("s_waitcnt vmcnt(0)" ::: "memory");
    __syncthreads();
    if (threadIdx.x == 0) {
        const unsigned x = xb_xcc_id();
        __builtin_amdgcn_s_waitcnt(0);
        unsigned nloc = st[0], nx = st[1];
        if (nloc == 0u) { xcd_barrier_complete(bar, x, nloc, nx); st[0] = nloc; st[1] = nx; }
        const unsigned old = xb_add(&bar[XB_XSUB(x)], 1u);
        const unsigned gen = old / nloc;
        if (old + 1u == (gen + 1u) * nloc) {
            __builtin_amdgcn_fence(__ATOMIC_RELEASE, "agent");
            asm volatile("s_waitcnt vmcnt(0)" ::: "memory");
            const unsigned og = xb_add(&bar[XB_TOP], 1u);
            const unsigned tg = og / nx;
            if (og + 1u == (tg + 1u) * nx) xb_add(&bar[XB_TOPGEN], 1u);
            else XB_SPIN(xb_ld(&bar[XB_TOPGEN]) == tg, bar);
            __builtin_amdgcn_fence(__ATOMIC_ACQUIRE, "agent");
            xb_add(&bar[XB_XGEN(x)], 1u);
            asm volatile("s_waitcnt vmcnt(0)" ::: "memory");
        } else {
            XB_SPIN(xb_ld(&bar[XB_XGEN(x)]) == gen, bar);
            __builtin_amdgcn_fence(__ATOMIC_ACQUIRE, "agent");
            asm volatile("s_waitcnt vmcnt(0)" ::: "memory");
        }
    }
    __syncthreads();
}

#define CG_SYNC() do { __threadfence(); grid.sync(); } while (0)
#define GRID_SYNC() xcd_barrier((unsigned*)WSP(), (volatile LAS unsigned*)(L + 131072 + 64))
__global__ void __launch_bounds__(NTHR, 2) mega_fwd(MegaArgs a_unused) {
    extern __shared__ __attribute__((aligned(16))) unsigned char lds_raw[];
    LAS unsigned char* L = (LAS unsigned char*)lds_raw;
    cg::grid_group grid = cg::this_grid();
    KArgs kp0 = (KArgs)__builtin_amdgcn_kernarg_segment_ptr();
#define KP() ({ KArgs p_ = kp0; asm volatile("" : "+s"(p_)); p_; })
#define WSP() (KP()->ws)
#define OUTP() (KP()->out)
#define INP(i) (KP()->in[i])
    {
        volatile LAS unsigned* st = (volatile LAS unsigned*)(L + 131072 + 64);
        if (threadIdx.x == 0) { st[0] = 0u; st[1] = 0u; (void)xb_add(&((unsigned*)WSP())[XB_XCNT(xb_xcc_id())], 1u); }
        __syncthreads();
    }
    prep_phase(KP(), L);
    CG_SYNC();
#pragma nounroll
    for (int l = 0; l < DEPTH; ++l) {
        {
            pg8::Gemm g{(h16*)(WSP() + WS_X16), (const h16*)(WSP() + WS_WIN) + (size_t)l * IN_PAD * D_MODEL, D_MODEL, D_MODEL, D_MODEL};
            pg8::StaticOrder S; { PHASE_IDS(); S.init(MTOK, IN_PAD, grd_, bid_); }
            pg8::EpiInProj E{(h16*)(WSP() + WS_P3), (h16*)(WSP() + WS_Q), (h16*)(WSP() + WS_KV), (h16*)(WSP() + WS_GATES)};
            pg8::gemm_phase<pg8::EpiInProj, pg8::StaticOrder, true>(L, g, S, E);
        }
        GRID_SYNC();
        elem_phase(WSP(), INP(2) + (size_t)l * 3 * CONV_W, INP(8) + (size_t)l * 1024);
        GRID_SYNC();
        {
            pg8::Gemm g{(const h16*)(WSP() + WS_KV), (const h16*)(WSP() + WS_CW1) + (size_t)l * 2 * CMP_H * CMP_K, 1024, CMP_K, CMP_K};
            pg8::CmpOrder S; { PHASE_IDS(); S.G = grd_; S.c = bid_; }
            pg8::EpiCmpH E{(h16*)(WSP() + WS_HCMP), (const float*)(WSP() + WS_CB1) + (size_t)l * 2 * CMP_H};
            pg8::gemm_phase<pg8::EpiCmpH, pg8::CmpOrder, true>(L, g, S, E);
        }
        GRID_SYNC();
        cmp2_phase(WSP(), INP(6) + (size_t)l * 2 * CMP_H * 64, INP(7) + (size_t)l * 2 * 64);
        GRID_SYNC();
        {   att::Ptrs P{(const h16*)(WSP() + WS_Q), (const h16*)(WSP() + WS_KV), (const h16*)(WSP() + WS_KCMP), (const h16*)(WSP() + WS_GATES), (h16*)(WSP() + WS_MIXED), INP(8) + (size_t)l * 1024};
            att::attn_phase(P, (LAS char*)L); }
        GRID_SYNC();
        {
            pg8::Gemm g{(const h16*)(WSP() + WS_MIXED), (const h16*)(WSP() + WS_WOUT) + (size_t)l * D_MODEL * D_MODEL, D_MODEL, D_MODEL, D_MODEL};
            pg8::StaticOrder S; { PHASE_IDS(); S.init(MTOK, D_MODEL, grd_, bid_); }
            pg8::EpiResid E{l == 0 ? INP(0) : OUTP(), OUTP(), D_MODEL};
            pg8::gemm_phase<pg8::EpiResid, pg8::StaticOrder, true>(L, g, S, E);
        }
        GRID_SYNC();
        ln_phase(OUTP(), (h16*)(WSP() + WS_X16), INP(10) + (size_t)l * 1024, INP(11) + (size_t)l * 1024);
        GRID_SYNC();
#pragma nounroll
        for (int hf = 0; hf < 2; ++hf) {
            const size_t r0 = (size_t)hf * (MTOK / 2);
            {   pg8::Gemm g{(h16*)(WSP() + WS_X16) + r0 * D_MODEL, (const h16*)(WSP() + WS_WUP) + (size_t)l * D_FF2 * D_MODEL, D_MODEL, D_MODEL, D_MODEL};
                pg8::StaticOrder S; { PHASE_IDS(); S.init(MTOK / 2, D_FF2, grd_, bid_); }
                pg8::EpiH16 E{(h16*)(WSP() + WS_U), D_FF2};
                pg8::gemm_phase<pg8::EpiH16, pg8::StaticOrder, true>(L, g, S, E); }
            GRID_SYNC();
            ffnact_phase((const h16*)(WSP() + WS_U), (h16*)(WSP() + WS_HID), INP(13) + (size_t)l * 3 * D_FF2, INP(14) + (size_t)l * D_FF2, MTOK / 2);
            GRID_SYNC();
            {   pg8::Gemm g{(const h16*)(WSP() + WS_HID), (const h16*)(WSP() + WS_WDN) + (size_t)l * D_MODEL * D_FF, D_FF, D_FF, D_FF};
                pg8::StaticOrder S; { PHASE_IDS(); S.init(MTOK / 2, D_MODEL, grd_, bid_); }
                float* o_ = OUTP() + r0 * D_MODEL; pg8::EpiResid E{o_, o_, D_MODEL};
                pg8::gemm_phase<pg8::EpiResid, pg8::StaticOrder, true>(L, g, S, E); }
            GRID_SYNC();
        }
        ln_phase(OUTP(), (h16*)(WSP() + WS_X16), INP(16) + (size_t)l * 1024, INP(17) + (size_t)l * 1024);
        if (l + 1 < DEPTH) GRID_SYNC();
    }
}

constexpr int MEGA_LDS = 147456;
extern "C" void kernel_launch(void* const* d_in, const int* in_sizes, int n_in, void* d_out, int out_size, void* d_ws, size_t ws_size, hipStream_t stream) {
    static int grid = 0;
    if (grid == 0) {
        if (n_in != 18 || in_sizes[0] != MTOK * D_MODEL || out_size != MTOK * D_MODEL || ws_size < WS_END) { fprintf(stderr, "kernel_launch: unexpected shapes (n_in %d, ws %zu)\n", n_in, ws_size); grid = -1; return; }
        int dev = 0, cus = 0, per_cu = 0;
        (void)hipGetDevice(&dev); (void)hipDeviceGetAttribute(&cus, hipDeviceAttributeMultiprocessorCount, dev);
        (void)hipFuncSetAttribute((const void*)mega_fwd, hipFuncAttributeMaxDynamicSharedMemorySize, MEGA_LDS);
        (void)hipOccupancyMaxActiveBlocksPerMultiprocessor(&per_cu, (const void*)mega_fwd, NTHR, MEGA_LDS);
        if (per_cu < 1) { fprintf(stderr, "kernel_launch: occupancy query says %d blocks/CU\n", per_cu); per_cu = 1; }
        grid = cus;
        fprintf(stderr, "kernel_launch: grid %d (cus %d, per_cu %d)\n", grid, cus, per_cu);
    }
    if (grid < 0) return;
    (void)hipMemsetAsync(d_ws, 0, 65536, stream);
    MegaArgs a{}; for (int i = 0; i < 18; ++i) a.in[i] = (const float*)d_in[i]; a.out = (float*)d_out; a.ws = (unsigned char*)d_ws;
    void* args[] = {&a};
    hipError_t e = hipLaunchCooperativeKernel((const void*)mega_fwd, dim3(grid), dim3(NTHR), args, MEGA_LDS, stream);
    if (e != hipSuccess) fprintf(stderr, "cooperative launch failed: %s (grid %d)\n", hipGetErrorString(e), grid);
}
```
